# Optimizing an MI355X kernel written in HIP

```python
import jax, jax.numpy as jnp
from jax import lax
import numpy as np

D_MODEL = 2048
BATCH = 16
SEQ = 256
DEPTH = 1
DEC_BATCH = 4
DEC_SEQ = 2048
PAST_LEN = 512

GRID_W = 64
N_HEADS_A = 16
HEAD_DIM_A = 64
WIDTH_A = N_HEADS_A * HEAD_DIM_A
NA_ROWS = 8
NA_COLS = 16
N_GROUPS_B = 8
GROUP_DIM_B = 128
WIDTH_B = N_GROUPS_B * GROUP_DIM_B
CHUNK = 128
MIX_WIDTH = WIDTH_A + WIDTH_B
IN_WIDTH = 3 * WIDTH_A + 2 * WIDTH_B
D_FF = 5632
N_MOD = 9
EPS = 1e-6
Q_BLOCK = 128
NEG_INF = -1e30

kernel_name = "hybrid_natten_gmlp_macaron_prefix_dit"


def rms_norm(x, g):
    xf = x.astype(jnp.float32)
    y = xf * lax.rsqrt(jnp.mean(xf * xf, axis=-1, keepdims=True) + EPS)
    return (y * g.astype(jnp.float32)).astype(x.dtype)


def adaln(cvec, w_ada, b_ada):
    m = jax.nn.silu(cvec) @ w_ada + b_ada
    return jnp.split(m, N_MOD, axis=-1)


def swiglu_sublayer(x, g, w_gate, w_up, w_down, shift, scale, gate):
    h = rms_norm(x, g) * (1 + scale) + shift
    f = (jax.nn.silu(h @ w_gate) * (h @ w_up)) @ w_down
    return x + 0.5 * gate * f


def mixer_inputs(x, g, w_in, shift, scale):
    B, L, _ = x.shape
    h = rms_norm(x, g) * (1 + scale) + shift
    p = h @ w_in
    q, k, v, u, vg = jnp.split(p, [WIDTH_A, 2 * WIDTH_A, 3 * WIDTH_A, 3 * WIDTH_A + WIDTH_B], axis=-1)
    shp = (B, L, N_HEADS_A, HEAD_DIM_A)
    return q.reshape(shp), k.reshape(shp), v.reshape(shp), u, vg


def spatial_gating(u, vg, norm_g, w_s, b_s):
    B, L, _ = u.shape
    u = jax.nn.gelu(u)
    vg = jax.nn.gelu(vg).reshape(B, L, N_GROUPS_B, GROUP_DIM_B)
    vg = rms_norm(vg, norm_g.reshape(N_GROUPS_B, GROUP_DIM_B))
    vc = vg.reshape(B, L // CHUNK, CHUNK, N_GROUPS_B, GROUP_DIM_B)
    s = jnp.einsum('gij,bnjgc->bnigc', w_s, vc) + b_s.T[None, None, :, :, None]
    return u * s.reshape(B, L, WIDTH_B)


def mixer_output(x, a, gm, na_g, nb_g, w_out, gate):
    y = jnp.concatenate([rms_norm(a, na_g), rms_norm(gm, nb_g)], axis=-1) @ w_out
    return x + gate * y


def context_attention(q, k, v):
    B, S, H, dh = q.shape
    qb = (q * dh ** -0.5).reshape(B, S // Q_BLOCK, Q_BLOCK, H, dh).transpose(1, 0, 2, 3, 4)

    def block(qi):
        s = jnp.einsum('bqhd,bkhd->bhqk', qi, k).astype(jnp.float32)
        p = jax.nn.softmax(s, axis=-1).astype(v.dtype)
        return jnp.einsum('bhqk,bkhd->bqhd', p, v)

    o = lax.map(block, qb)
    return o.transpose(1, 0, 2, 3, 4).reshape(B, S, H * dh)


def neighbourhood_attention(q, k, v, ctx_k, ctx_v, rpb):
    B, N, H, dh = q.shape
    rows = N // GRID_W
    kr = min(NA_ROWS, rows)
    r = jnp.arange(rows)
    row_start = jnp.clip(r - kr // 2, 0, rows - kr)
    row_idx = row_start[:, None] + jnp.arange(kr)[None, :]
    col = jnp.arange(GRID_W)
    col_start = jnp.clip(col - NA_COLS // 2, 0, GRID_W - NA_COLS)
    col_mask = (col[None, :] >= col_start[:, None]) & (col[None, :] < col_start[:, None] + NA_COLS)
    dr = row_idx - r[:, None]
    dc_idx = jnp.clip(col[None, :] - col[:, None] + NA_COLS - 1, 0, 2 * NA_COLS - 2)
    bias = rpb[:, dr + NA_ROWS - 1][..., dc_idx]
    bias = bias.transpose(0, 1, 3, 2, 4).astype(jnp.float32)
    bias = jnp.where(col_mask[None, None, :, None, :], bias, NEG_INF)

    qs = (q * dh ** -0.5).reshape(B, rows, GRID_W, H, dh)
    kg = k.reshape(B, rows, GRID_W, H, dh)[:, row_idx]
    vg = v.reshape(B, rows, GRID_W, H, dh)[:, row_idx]
    s_loc = jnp.einsum('brqhd,brkwhd->bhrqkw', qs, kg).astype(jnp.float32) + bias[None]
    s_ctx = jnp.einsum('brqhd,bphd->bhrqp', qs, ctx_k).astype(jnp.float32)
    n_loc = kr * GRID_W
    s = jnp.concatenate([s_loc.reshape(B, H, rows, GRID_W, n_loc), s_ctx], axis=-1)
    p = jax.nn.softmax(s, axis=-1).astype(v.dtype)
    p_loc = p[..., :n_loc].reshape(B, H, rows, GRID_W, kr, GRID_W)
    p_ctx = p[..., n_loc:]
    o = (jnp.einsum('bhrqkw,brkwhd->brqhd', p_loc, vg)
         + jnp.einsum('bhrqp,bphd->brqhd', p_ctx, ctx_v))
    return o.reshape(B, N, H * dh)


def setup_inputs(seed: int = 0) -> dict:
    key = jax.random.key(seed)
    ks = jax.random.split(key, 26)
    f32 = jnp.float32
    D, L = D_MODEL, DEPTH

    def nrm(k, shape, s):
        return jax.random.normal(k, shape, f32) * s

    def gain(k, shape):
        return 1.0 + 0.01 * jax.random.normal(k, shape, f32)

    return {
        "x_prompt": nrm(ks[0], (BATCH, SEQ, D), 1.0),
        "x_sample": nrm(ks[1], (DEC_BATCH, DEC_SEQ, D), 1.0),
        "cache_k": nrm(ks[2], (DEC_BATCH, L, PAST_LEN, N_HEADS_A, HEAD_DIM_A), 1.0),
        "cache_v": nrm(ks[3], (DEC_BATCH, L, PAST_LEN, N_HEADS_A, HEAD_DIM_A), 1.0),
        "c": nrm(ks[4], (DEC_BATCH, D), 1.0),
        "c_ctx": nrm(ks[5], (D,), 1.0),
        "w_ada": nrm(ks[6], (L, D, N_MOD * D), 0.1 * D ** -0.5),
        "b_ada": nrm(ks[7], (L, N_MOD * D), 0.01),
        "ffn1_norm": gain(ks[8], (L, D)),
        "ffn1_w_gate": nrm(ks[9], (L, D, D_FF), D ** -0.5),
        "ffn1_w_up": nrm(ks[10], (L, D, D_FF), D ** -0.5),
        "ffn1_w_down": nrm(ks[11], (L, D_FF, D), D_FF ** -0.5),
        "mix_norm": gain(ks[12], (L, D)),
        "w_in": nrm(ks[13], (L, D, IN_WIDTH), D ** -0.5),
        "rpb": nrm(ks[14], (L, N_HEADS_A, 2 * NA_ROWS - 1, 2 * NA_COLS - 1), 0.1),
        "gmlp_norm": gain(ks[15], (L, WIDTH_B)),
        "w_s": nrm(ks[16], (L, N_GROUPS_B, CHUNK, CHUNK), CHUNK ** -0.5),
        "b_s": gain(ks[17], (L, N_GROUPS_B, CHUNK)),
        "out_norm_a": gain(ks[18], (L, WIDTH_A)),
        "out_norm_b": gain(ks[19], (L, WIDTH_B)),
        "w_out": nrm(ks[20], (L, MIX_WIDTH, D), MIX_WIDTH ** -0.5),
        "ffn2_norm": gain(ks[21], (L, D)),
        "ffn2_w_gate": nrm(ks[22], (L, D, D_FF), D ** -0.5),
        "ffn2_w_up": nrm(ks[23], (L, D, D_FF), D ** -0.5),
        "ffn2_w_down": nrm(ks[24], (L, D_FF, D), D_FF ** -0.5),
        "final_norm": gain(ks[25], (D,)),
    }


def reference(x_prompt, x_sample, cache_k, cache_v, c, c_ctx, w_ada, b_ada,
              ffn1_norm, ffn1_w_gate, ffn1_w_up, ffn1_w_down,
              mix_norm, w_in, rpb, gmlp_norm, w_s, b_s, out_norm_a, out_norm_b, w_out,
              ffn2_norm, ffn2_w_gate, ffn2_w_up, ffn2_w_down, final_norm):
    x_ctx = x_prompt
    x_lat = x_sample
    new_k = []
    new_v = []
    for l in range(DEPTH):
        m_ctx = adaln(c_ctx, w_ada[l], b_ada[l])
        m_lat = [m[:, None, :] for m in adaln(c, w_ada[l], b_ada[l])]

        x_ctx = swiglu_sublayer(x_ctx, ffn1_norm[l], ffn1_w_gate[l], ffn1_w_up[l], ffn1_w_down[l],
                                m_ctx[0], m_ctx[1], m_ctx[2])
        q, k, v, u, vg = mixer_inputs(x_ctx, mix_norm[l], w_in[l], m_ctx[3], m_ctx[4])
        a = context_attention(q, k, v)
        gm = spatial_gating(u, vg, gmlp_norm[l], w_s[l], b_s[l])
        x_ctx = mixer_output(x_ctx, a, gm, out_norm_a[l], out_norm_b[l], w_out[l], m_ctx[5])
        x_ctx = swiglu_sublayer(x_ctx, ffn2_norm[l], ffn2_w_gate[l], ffn2_w_up[l], ffn2_w_down[l],
                                m_ctx[6], m_ctx[7], m_ctx[8])
        new_k.append(k)
        new_v.append(v)

        x_lat = swiglu_sublayer(x_lat, ffn1_norm[l], ffn1_w_gate[l], ffn1_w_up[l], ffn1_w_down[l],
                                m_lat[0], m_lat[1], m_lat[2])
        q, k, v, u, vg = mixer_inputs(x_lat, mix_norm[l], w_in[l], m_lat[3], m_lat[4])
        a = neighbourhood_attention(q, k, v, cache_k[:, l], cache_v[:, l], rpb[l])
        gm = spatial_gating(u, vg, gmlp_norm[l], w_s[l], b_s[l])
        x_lat = mixer_output(x_lat, a, gm, out_norm_a[l], out_norm_b[l], w_out[l], m_lat[5])
        x_lat = swiglu_sublayer(x_lat, ffn2_norm[l], ffn2_w_gate[l], ffn2_w_up[l], ffn2_w_down[l],
                                m_lat[6], m_lat[7], m_lat[8])

    y_prompt = rms_norm(x_ctx, final_norm)
    y_sample = rms_norm(x_lat, final_norm)
    state_k = jnp.stack(new_k, axis=1)
    state_v = jnp.stack(new_v, axis=1)
    return (y_prompt, y_sample, state_k, state_v)
```

```cpp
#include <hip/hip_runtime.h>
#include <cstdio>
#include <cstdint>
namespace pg8 {
#define PG8_LAS __attribute__((address_space(3)))
typedef unsigned short bf16_t;
typedef short bf16x8 __attribute__((ext_vector_type(8)));
typedef float f32x4 __attribute__((ext_vector_type(4)));
typedef unsigned u32x4 __attribute__((ext_vector_type(4)));
constexpr int BM = 256, BK = 64, HALF = 128, HTB = HALF * BK * 2  , STAGE_BYTES = 8 * HTB, NXCD = 8, WGM = 8;

__host__ __device__ __forceinline__ int lds_byte(int r, int c) { const int st = (r >> 4) * 2 + (c >> 5), rr = r & 15, cc = c & 31, ob = rr * 64 + cc * 2; return st * 1024 + (ob ^ (((ob >> 9) & 1) << 5)); }
__host__ __device__ __forceinline__ void stage_rc(int b, int& R, int& C) { const int st = b / 1024, sb = b % 1024, swz = sb ^ (((sb >> 9) & 1) << 5); R = (st >> 1) * 16 + swz / 64; C = (st & 1) * 32 + (swz % 64) / 2; }
__host__ __device__ __forceinline__ int perm32(int rho) { const int n = rho >> 4, i = rho & 15; return 8 * (i >> 2) + 4 * n + (i & 3); }

struct Unit { int pm, pn; };
struct Gemm { const bf16_t* A; const bf16_t* Bt; int M, N, K; };

struct StaticOrder {
    int nM, nN, nwg, G, c;
    __host__ __device__ void init(int M, int N, int G_, int c_) { nM = M / BM; nN = N / BM; nwg = nM * nN; G = G_; c = c_; }
    __host__ __device__ bool next(int i, Unit& u) const {
        const long L = (long)i * G + c; if (L >= nwg) return false;
        int wgid = (int)L; { const int q = nwg / NXCD, r = nwg % NXCD, xcd = wgid % NXCD, off = wgid / NXCD; wgid = (xcd < r ? xcd * (q + 1) : r * (q + 1) + (xcd - r) * q) + off; }
        const int nig = WGM * nN, gid = wgid / nig, fm = gid * WGM, gsz = (nM - fm) < WGM ? (nM - fm) : WGM;
        u.pm = fm + ((wgid % nig) % gsz); u.pn = (wgid % nig) / gsz; return true;
    }
    __device__ __forceinline__ void a_ready(const Unit&) const {}
    __device__ __forceinline__ void done(const Unit&) const {}
};

__device__ __forceinline__ unsigned cvt_pk_bf16(float lo, float hi) { unsigned r; asm volatile("v_cvt_pk_bf16_f32 %0, %1, %2" : "=v"(r) : "v"(lo), "v"(hi)); return r; }
typedef float f32x2 __attribute__((ext_vector_type(2)));
typedef unsigned u32x2 __attribute__((ext_vector_type(2)));
constexpr float LOG2E = 1.4426950408889634f;
__device__ __forceinline__ float silu_f(float g) { return g * __builtin_amdgcn_rcpf(1.0f + __builtin_amdgcn_exp2f(-LOG2E * g)); }
__device__ __forceinline__ float gelu_tanh_f(float x) { const float t = x * (-2.3022081983f + -0.1029432407f * x * x); return x * __builtin_amdgcn_rcpf(1.0f + __builtin_amdgcn_exp2f(t)); }

__device__ __forceinline__ int mod_set_of_tile(int pm) { return pm < 16 ? 0 : 1 + ((pm - 16) >> 3); }
constexpr int MOD_JSTRIDE = 9 * 2048;

struct EpiSwiGLU {
    static constexpr bool PERM = true, AFTER_DRAIN = false;
    bf16_t* O; int ldc;
    __device__ __forceinline__ void operator()(const f32x4 (&acc)[2][2][4][2], const Unit& u, int wr, int wc, int fr, int fq) const {
        const int row0 = u.pm * BM + wr * 64 + fr, col0 = u.pn * HALF + wc * 32 + 8 * fq;
#pragma unroll
        for (int ai = 0; ai < 2; ++ai)
#pragma unroll
            for (int m = 0; m < 4; ++m) { bf16_t* rowp = O + (size_t)(row0 + ai * HALF + m * 16) * ldc + col0;
                const f32x4 g0 = acc[ai][0][m][0], g1 = acc[ai][0][m][1], u0 = acc[ai][1][m][0], u1 = acc[ai][1][m][1];
                u32x4 w; w.x = cvt_pk_bf16(silu_f(g0[0]) * u0[0], silu_f(g0[1]) * u0[1]); w.y = cvt_pk_bf16(silu_f(g0[2]) * u0[2], silu_f(g0[3]) * u0[3]);
                w.z = cvt_pk_bf16(silu_f(g1[0]) * u1[0], silu_f(g1[1]) * u1[1]); w.w = cvt_pk_bf16(silu_f(g1[2]) * u1[2], silu_f(g1[3]) * u1[3]);
                *(u32x4*)rowp = w; }
    }
};

struct EpiRes {
    static constexpr bool PERM = false, AFTER_DRAIN = false;
    const float* base_ctx; const float* base_lat; float* out; const float* gtab; int ldc;
    __device__ __forceinline__ void operator()(const f32x4 (&acc)[2][2][4][2], const Unit& u, int wr, int wc, int fr, int fq) const {
        const int row0 = u.pm * BM + wr * 64 + fr, col0 = u.pn * BM + wc * 32 + 4 * fq;
        const float* gv = gtab + (size_t)mod_set_of_tile(u.pm) * MOD_JSTRIDE;
        const float* bbase = u.pm < 16 ? base_ctx : base_lat; const int brow0 = u.pm < 16 ? row0 : row0 - 4096;
        f32x4 gvv[2][2];
#pragma unroll
        for (int bj = 0; bj < 2; ++bj)
#pragma unroll
            for (int n = 0; n < 2; ++n) gvv[bj][n] = *(const f32x4*)(gv + col0 + bj * HALF + n * 16);
#pragma unroll
        for (int ai = 0; ai < 2; ++ai)
#pragma unroll
            for (int m = 0; m < 4; ++m) { const size_t boff = (size_t)(brow0 + ai * HALF + m * 16) * ldc + col0, ooff = (size_t)(row0 + ai * HALF + m * 16) * ldc + col0;
#pragma unroll
                for (int bj = 0; bj < 2; ++bj)
#pragma unroll
                    for (int n = 0; n < 2; ++n) { const f32x4 bs = *(const f32x4*)(bbase + boff + bj * HALF + n * 16);
                        *(f32x4*)(out + ooff + bj * HALF + n * 16) = bs + gvv[bj][n] * acc[ai][bj][m][n]; } }
    }
};

struct EpiMixIn {
    static constexpr bool PERM = true, AFTER_DRAIN = false;
    bf16_t* qb; bf16_t* kb; bf16_t* vb; bf16_t* ub; bf16_t* vgb; float* state_k; float* state_v; float qscale;
    __device__ __forceinline__ void operator()(const f32x4 (&acc)[2][2][4][2], const Unit& u, int wr, int wc, int fr, int fq) const {
        const int row0 = u.pm * BM + wr * 64 + fr;
#pragma unroll
        for (int bj = 0; bj < 2; ++bj) {
            const int colg = u.pn * BM + bj * HALF, region = colg >> 10, cb = (colg & 1023) + wc * 32 + 8 * fq;
            bf16_t* dst = region == 0 ? qb : region == 1 ? kb : region == 2 ? vb : region == 3 ? ub : vgb;
            float* st = region == 1 ? state_k : state_v; const bool wst = (region == 1 || region == 2) && u.pm < 16;
#pragma unroll
            for (int ai = 0; ai < 2; ++ai)
#pragma unroll
                for (int m = 0; m < 4; ++m) { const int row = row0 + ai * HALF + m * 16; f32x4 v0 = acc[ai][bj][m][0], v1 = acc[ai][bj][m][1];
                    if (wst) { *(f32x4*)(st + (size_t)row * 1024 + cb) = v0; *(f32x4*)(st + (size_t)row * 1024 + cb + 4) = v1; }
                    if (region == 0) { v0 = v0 * qscale; v1 = v1 * qscale; }
                    if (region >= 3) {
#pragma unroll
                        for (int i = 0; i < 4; ++i) { v0[i] = gelu_tanh_f(v0[i]); v1[i] = gelu_tanh_f(v1[i]); } }
                    u32x4 w; w.x = cvt_pk_bf16(v0[0], v0[1]); w.y = cvt_pk_bf16(v0[2], v0[3]); w.z = cvt_pk_bf16(v1[0], v1[1]); w.w = cvt_pk_bf16(v1[2], v1[3]);
                    *(u32x4*)(dst + (size_t)row * 1024 + cb) = w; }
        }
    }
};

template <class Epi, class Sched, bool ALIGN_EPI = false, bool SP2 = false>
__device__ __forceinline__ void gemm_phase(PG8_LAS unsigned char* lds, const Gemm g, const Sched& S, const Epi& E) {
    const int tid = threadIdx.x, wid = __builtin_amdgcn_readfirstlane(tid >> 6), lane = tid & 63, wr = wid >> 2, wc = wid & 3, fr = lane & 15, fq = lane >> 4;
    const int K = g.K, nt = K / BK;
    unsigned voffA[2], voffB[2];
#pragma unroll
    for (int i = 0; i < 2; ++i) { int R, C; stage_rc(tid * 16 + i * 8192, R, C); const int Rb = Epi::PERM ? ((R & ~31) + perm32(R & 31)) : R;
        voffA[i] = (unsigned)(R * K + C) * 2u; voffB[i] = (unsigned)(Rb * K + C) * 2u; }
    const size_t kstep = (size_t)(BK * 2);
    const size_t hstep = (size_t)HALF * K * 2;
    const size_t tstep = 2 * hstep;
    const unsigned ldsw = (unsigned)wid * 1024u;
    const int aoff = lds_byte(wr * 64 + fr, fq * 8), boff = lds_byte(wc * 32 + fr, fq * 8);
#define PG8_SA(b, h) (((b) * 2 + (h)) * HTB)
#define PG8_SB(b, h) ((4 + (b) * 2 + (h)) * HTB)
#define PG8_STAGE(bufoff, gbase, voff) do { _Pragma("unroll") for (int _i = 0; _i < 2; ++_i) \
        __builtin_amdgcn_global_load_lds((const unsigned*)((const char*)(gbase) + (voff)[_i]), (PG8_LAS unsigned*)(lds + (bufoff) + ldsw + _i * 8192), 16, 0, 0); } while (0)
#define PG8_LDA(dst, b, h) do { _Pragma("unroll") for (int m = 0; m < 4; ++m) _Pragma("unroll") for (int k = 0; k < 2; ++k) dst[m][k] = *(const PG8_LAS bf16x8*)(lds + PG8_SA(b, h) + aoff + m * 2048 + k * 1024); } while (0)
#define PG8_LDB(dst, b, h) do { _Pragma("unroll") for (int n = 0; n < 2; ++n) _Pragma("unroll") for (int k = 0; k < 2; ++k) dst[n][k] = *(const PG8_LAS bf16x8*)(lds + PG8_SB(b, h) + boff + n * 2048 + k * 1024); } while (0)
#define PG8_MMA(ai, bj, At, Bt) do { __builtin_amdgcn_s_setprio(1); _Pragma("unroll") for (int m = 0; m < 4; ++m) _Pragma("unroll") for (int n = 0; n < 2; ++n) _Pragma("unroll") for (int k = 0; k < 2; ++k) \
        acc[ai][bj][m][n] = __builtin_amdgcn_mfma_f32_16x16x32_bf16(Bt[n][k], At[m][k], acc[ai][bj][m][n], 0, 0, 0); __builtin_amdgcn_s_setprio(0); } while (0)
#define PG8_WAIT_V(n) asm volatile("s_waitcnt vmcnt(" #n ")" ::: "memory")
#define PG8_WAIT_L(n) asm volatile("s_waitcnt lgkmcnt(" #n ")" ::: "memory")
#define PG8_BAR __builtin_amdgcn_s_barrier()
#define PG8_SCHED __builtin_amdgcn_sched_barrier(0)
    Unit cur, nxt; int ui = 0;
    if (!S.next(0, cur)) return;
    f32x4 acc[2][2][4][2];
#pragma unroll
    for (int a = 0; a < 2; ++a)
#pragma unroll
        for (int b = 0; b < 2; ++b)
#pragma unroll
            for (int m = 0; m < 4; ++m)
#pragma unroll
                for (int n = 0; n < 2; ++n) acc[a][b][m][n] = (f32x4){0.f, 0.f, 0.f, 0.f};
    bf16x8 At[4][2], B0[2][2], B1[2][2];
    const char* cA = (const char*)g.A + (size_t)cur.pm * tstep; const char* cB = (const char*)g.Bt + (size_t)cur.pn * tstep;
    S.a_ready(cur);
    if constexpr (SP2) {
        PG8_STAGE(PG8_SB(0, 0), cB, voffB); PG8_STAGE(PG8_SB(0, 1), cB + hstep, voffB); PG8_STAGE(PG8_SA(0, 0), cA, voffA); PG8_STAGE(PG8_SA(0, 1), cA + hstep, voffA);
        if (wr == 1) PG8_BAR;
        PG8_WAIT_V(2); PG8_BAR;
        PG8_STAGE(PG8_SB(1, 0), cB + kstep, voffB); PG8_STAGE(PG8_SA(1, 0), cA + kstep, voffA); PG8_STAGE(PG8_SB(1, 1), cB + hstep + kstep, voffB);
        PG8_WAIT_V(6); PG8_BAR;
    } else {
        PG8_STAGE(PG8_SB(0, 0), cB, voffB); PG8_STAGE(PG8_SA(0, 0), cA, voffA); PG8_STAGE(PG8_SB(0, 1), cB + hstep, voffB); PG8_STAGE(PG8_SA(0, 1), cA + hstep, voffA);
        if (wr == 1) PG8_BAR;
        PG8_WAIT_V(4); PG8_BAR;
        PG8_STAGE(PG8_SB(1, 0), cB + kstep, voffB); PG8_STAGE(PG8_SA(1, 0), cA + kstep, voffA); PG8_STAGE(PG8_SB(1, 1), cB + hstep + kstep, voffB);
        PG8_WAIT_V(6); PG8_BAR;
    }
    for (;;) {
        const bool has_next = S.next(ui + 1, nxt);
        const char* nA = has_next ? (const char*)g.A + (size_t)nxt.pm * tstep : cA; const char* nB = has_next ? (const char*)g.Bt + (size_t)nxt.pn * tstep : cB;
        for (int t = 0; t < nt; t += 2) {
            const bool last = (t == nt - 2);
            const char* a1 = cA + (size_t)(t + 1) * kstep;
            const char* a2 = last ? nA : cA + (size_t)(t + 2) * kstep; const char* b2 = last ? nB : cB + (size_t)(t + 2) * kstep;
            const char* a3 = a2 + kstep; const char* b3 = b2 + kstep;
            if (last && has_next) S.a_ready(nxt);
            if constexpr (SP2) {
            PG8_LDB(B0, 0, 0); PG8_LDB(B1, 0, 1); PG8_SCHED; PG8_LDA(At, 0, 0); PG8_STAGE(PG8_SA(1, 1), a1 + hstep, voffA);
            PG8_WAIT_V(8); PG8_WAIT_L(0); PG8_BAR; PG8_MMA(0, 0, At, B0); PG8_MMA(0, 1, At, B1); PG8_BAR; PG8_SCHED;
            PG8_LDA(At, 0, 1); PG8_STAGE(PG8_SB(0, 0), b2, voffB); PG8_STAGE(PG8_SB(0, 1), b2 + hstep, voffB); PG8_STAGE(PG8_SA(0, 0), a2, voffA);
            PG8_WAIT_V(8); PG8_WAIT_L(0); PG8_BAR; PG8_MMA(1, 0, At, B0); PG8_MMA(1, 1, At, B1); PG8_BAR; PG8_SCHED;
            PG8_LDB(B0, 1, 0); PG8_LDB(B1, 1, 1); PG8_SCHED; PG8_LDA(At, 1, 0); PG8_STAGE(PG8_SA(0, 1), a2 + hstep, voffA);
            PG8_WAIT_V(8); PG8_WAIT_L(0); PG8_BAR; PG8_MMA(0, 0, At, B0); PG8_MMA(0, 1, At, B1); PG8_BAR; PG8_SCHED;
            PG8_LDA(At, 1, 1); PG8_STAGE(PG8_SB(1, 0), b3, voffB); PG8_STAGE(PG8_SB(1, 1), b3 + hstep, voffB); PG8_STAGE(PG8_SA(1, 0), a3, voffA);
            PG8_WAIT_V(8); PG8_WAIT_L(0); PG8_BAR; PG8_MMA(1, 0, At, B0); PG8_MMA(1, 1, At, B1); PG8_BAR; PG8_SCHED;
            } else {
            PG8_LDB(B0, 0, 0); PG8_SCHED; PG8_LDA(At, 0, 0); PG8_STAGE(PG8_SA(1, 1), a1 + hstep, voffA);
            PG8_WAIT_L(8); PG8_BAR; PG8_WAIT_L(0); PG8_MMA(0, 0, At, B0); PG8_BAR; PG8_SCHED;
            PG8_LDB(B1, 0, 1); PG8_STAGE(PG8_SB(0, 0), b2, voffB);
            PG8_BAR; PG8_WAIT_L(0); PG8_MMA(0, 1, At, B1); PG8_BAR;
            PG8_LDA(At, 0, 1); PG8_STAGE(PG8_SA(0, 0), a2, voffA);
            PG8_BAR; PG8_WAIT_L(0); PG8_MMA(1, 0, At, B0); PG8_BAR; PG8_SCHED;
            PG8_STAGE(PG8_SB(0, 1), b2 + hstep, voffB);
            PG8_WAIT_V(6); PG8_BAR; PG8_MMA(1, 1, At, B1); PG8_BAR;
            PG8_LDB(B0, 1, 0); PG8_SCHED; PG8_LDA(At, 1, 0); PG8_STAGE(PG8_SA(0, 1), a2 + hstep, voffA);
            PG8_WAIT_L(8); PG8_BAR; PG8_WAIT_L(0); PG8_MMA(0, 0, At, B0); PG8_BAR; PG8_SCHED;
            PG8_LDB(B1, 1, 1); PG8_STAGE(PG8_SB(1, 0), b3, voffB);
            PG8_BAR; PG8_WAIT_L(0); PG8_MMA(0, 1, At, B1); PG8_BAR;
            PG8_LDA(At, 1, 1); PG8_STAGE(PG8_SA(1, 0), a3, voffA);
            PG8_BAR; PG8_WAIT_L(0); PG8_MMA(1, 0, At, B0); PG8_BAR; PG8_SCHED;
            PG8_STAGE(PG8_SB(1, 1), b3 + hstep, voffB);
            PG8_WAIT_V(6); PG8_BAR; PG8_MMA(1, 1, At, B1); PG8_BAR;
            }
        }
        if constexpr (ALIGN_EPI) { if (wr == 0) PG8_BAR; }
        if constexpr (!Epi::AFTER_DRAIN) { E(acc, cur, wr, wc, fr, fq); S.done(cur); }
        if (!has_next) break;
#pragma unroll
        for (int a = 0; a < 2; ++a)
#pragma unroll
            for (int b = 0; b < 2; ++b)
#pragma unroll
                for (int m = 0; m < 4; ++m)
#pragma unroll
                    for (int n = 0; n < 2; ++n) acc[a][b][m][n] = (f32x4){0.f, 0.f, 0.f, 0.f};
        cur = nxt; cA = nA; cB = nB; ++ui;
        if constexpr (ALIGN_EPI) { if (wr == 1) PG8_BAR; }
    }
    PG8_WAIT_V(0);
    if constexpr (!ALIGN_EPI) { if (wr == 0) PG8_BAR; }
    PG8_BAR;
    if constexpr (Epi::AFTER_DRAIN) { E.fused(acc, cur, wr, wc, fr, fq, lds, wid, lane); S.done(cur); }
#undef PG8_SA
#undef PG8_SB
#undef PG8_STAGE
#undef PG8_LDA
#undef PG8_LDB
#undef PG8_MMA
#undef PG8_WAIT_V
#undef PG8_WAIT_L
#undef PG8_BAR
#undef PG8_SCHED
}
}
#define GAS __attribute__((address_space(1)))
#define LAS __attribute__((address_space(3)))
typedef unsigned short bf16;
typedef unsigned v4u __attribute__((ext_vector_type(4)));
typedef float f32x4 __attribute__((ext_vector_type(4)));
typedef short bf16x8 __attribute__((ext_vector_type(8)));
typedef GAS unsigned gu32;
typedef GAS unsigned long long gu64;
#define RLX_AGENT __ATOMIC_RELAXED, __HIP_MEMORY_SCOPE_AGENT
#define LDS_WAIT() asm volatile("s_waitcnt lgkmcnt(0)" ::: "memory")
#define VM_WAIT() asm volatile("s_waitcnt vmcnt(0)" ::: "memory")
__device__ __forceinline__ unsigned long long rt() { return __builtin_amdgcn_s_memrealtime(); }
__device__ __forceinline__ unsigned f2bf(float f) { unsigned u = __builtin_bit_cast(unsigned, f); return (u + 0x7fffu + ((u >> 16) & 1u)) >> 16; }
__device__ __forceinline__ unsigned pk2(float lo, float hi) { return f2bf(lo) | (f2bf(hi) << 16); }

#define XB_TMO      128
#define XB_XCNT(j)  (256  + 64 * (j))
#define XB_XSUB(j)  (1280 + 64 * (j))
#define XB_XGEN(j)  (2304 + 64 * (j))
#define XB_TOP      3328
#define XB_TOPGEN   3392
#define XCD_BAR_WORDS 3456
#define XB_SPIN_CAP (1u << 18)

__device__ __forceinline__ unsigned xb_ld(unsigned* p)              { return __hip_atomic_load(p, __ATOMIC_RELAXED, __HIP_MEMORY_SCOPE_AGENT); }
__device__ __forceinline__ unsigned xb_add(unsigned* p, unsigned v) { return __hip_atomic_fetch_add(p, v, __ATOMIC_RELAXED, __HIP_MEMORY_SCOPE_AGENT); }
__device__ __forceinline__ unsigned xb_xcc_id() { return (unsigned)__builtin_amdgcn_s_getreg((3 << 11) | 20) & 0xFu; }
#define XB_SPIN(cond, bar) do { unsigned _sp = 0; while (cond) { __builtin_amdgcn_s_sleep(1); \
    if ((++_sp & 255u) == 0u) { if (xb_ld(&(bar)[XB_TMO])) break; if (_sp > XB_SPIN_CAP) { atomicAdd(&(bar)[XB_TMO], 1u); break; } } } } while (0)

struct XcdBarrier {
    unsigned* bar; unsigned x;
    volatile LAS unsigned* st;
};

__device__ __forceinline__ XcdBarrier xcd_barrier_post(unsigned* bar, volatile LAS unsigned* st) {
    XcdBarrier b; b.bar = bar; b.x = xb_xcc_id(); b.st = st;
    if (threadIdx.x == 0) (void)xb_add(&bar[XB_XCNT(b.x)], 1u);
    return b;
}
__device__ __forceinline__ void xcd_barrier_complete(unsigned* bar, unsigned x, unsigned& nloc, unsigned& nx) {
    const unsigned G = gridDim.x * gridDim.y * gridDim.z;
    unsigned sum, cnt, mine, sp = 0u;
    for (;;) {
        sum = 0u; cnt = 0u; mine = 0u;
#pragma unroll
        for (unsigned j = 0; j < 16; ++j) { const unsigned c = xb_ld(&bar[XB_XCNT(j)]); sum += c; cnt += (c > 0u) ? 1u : 0u; mine = (j == x) ? c : mine; }
        if (sum == G) break;
        __builtin_amdgcn_s_sleep(1);
        if ((++sp & 255u) == 0u) { if (xb_ld(&bar[XB_TMO])) break; if (sp > XB_SPIN_CAP) { atomicAdd(&bar[XB_TMO], 1u); break; } }
    }
    nloc = mine > 0u ? mine : 1u; nx = cnt > 0u ? cnt : 1u;
}

__device__ __forceinline__ void xcd_barrier(const XcdBarrier& b) {
    asm volatile("s_waitcnt vmcnt(0)" ::: "memory");
    __syncthreads();
    if (threadIdx.x == 0) {
        unsigned* bar = b.bar;
        __builtin_amdgcn_s_waitcnt(0);
        unsigned nloc = b.st[0], nx = b.st[1];
        if (nloc == 0u) { xcd_barrier_complete(bar, b.x, nloc, nx); b.st[0] = nloc; b.st[1] = nx; }
        const unsigned old = xb_add(&bar[XB_XSUB(b.x)], 1u);
        const unsigned gen = old / nloc;
        if (old + 1u == (gen + 1u) * nloc) {
            __builtin_amdgcn_fence(__ATOMIC_RELEASE, "agent");
            asm volatile("s_waitcnt vmcnt(0)" ::: "memory");
            const unsigned og = xb_add(&bar[XB_TOP], 1u);
            const unsigned tg = og / nx;
            if (og + 1u == (tg + 1u) * nx) xb_add(&bar[XB_TOPGEN], 1u);
            else XB_SPIN(xb_ld(&bar[XB_TOPGEN]) == tg, bar);
            __builtin_amdgcn_fence(__ATOMIC_ACQUIRE, "agent");
            xb_add(&bar[XB_XGEN(b.x)], 1u);
            asm volatile("s_waitcnt vmcnt(0)" ::: "memory");
        } else {
            XB_SPIN(xb_ld(&bar[XB_XGEN(b.x)]) == gen, bar);
            __builtin_amdgcn_fence(__ATOMIC_ACQUIRE, "agent");
            asm volatile("s_waitcnt vmcnt(0)" ::: "memory");
        }
    }
    __syncthreads();
}

constexpr int NWAVES = 8;
constexpr int DM = 2048, MCTX = 4096, MLAT = 8192, MTOK = MCTX + MLAT, DFF = 5632, INW = 5120, WA = 1024, NADA = 9 * DM;
constexpr float EPS = 1e-6f;
constexpr float LOG2E_F = 1.4426950408889634f;
constexpr int KSPLIT_ADA = 16, ADA_ROWS = DM / KSPLIT_ADA;
constexpr int NSET = 5;

constexpr size_t MiB = 1u << 20;
constexpr size_t WS_CTL = 0, CTL_ZERO_BYTES = 1 * MiB;
constexpr size_t WS_MODP = 1 * MiB;
constexpr size_t WS_MOD = 7 * MiB;
constexpr size_t WS_CK = 8 * MiB, WS_CV = 12 * MiB;
constexpr size_t WS_WGU1 = 16 * MiB, WS_WD1 = 60 * MiB, WS_WIN = 82 * MiB, WS_WOUT = 102 * MiB, WS_WGU2 = 110 * MiB, WS_WD2 = 154 * MiB;
constexpr size_t WS_H = 176 * MiB;
constexpr size_t WS_ACT = 224 * MiB;
constexpr size_t WS_Q = 356 * MiB, WS_K = 380 * MiB, WS_V = 404 * MiB, WS_U = 428 * MiB, WS_VG = 452 * MiB;
constexpr size_t WS_MIX = 476 * MiB;
constexpr size_t WS_END = 524 * MiB;
constexpr int CW_BAR = 4096;

constexpr int RING_OFF = 0, RING_BYTES = 131072;
constexpr int LDSCTL_OFF = RING_BYTES, MISC_OFF = LDSCTL_OFF + 320;
constexpr int LDS_BYTES = 147456;

struct Frame {
    LAS unsigned char* lds;
    volatile LAS unsigned* MISC;
    gu32* ctl;
    int tid, lane, wave;
    int vcu, G;
};

__device__ __forceinline__ float wave_sum(float v) {
#pragma unroll
    for (int o = 1; o < 64; o <<= 1) v += __shfl_xor(v, o);
    return v;
}
__device__ __forceinline__ float bf2f(unsigned short b) { return __builtin_bit_cast(float, (unsigned)b << 16); }
__device__ __forceinline__ float bflo(unsigned w) { return __builtin_bit_cast(float, w << 16); }
__device__ __forceinline__ float bfhi(unsigned w) { return __builtin_bit_cast(float, w & 0xffff0000u); }

__device__ __forceinline__ void p0_transpose_item(const float* W, int K, int N, bf16* WT, int mode, LAS float* scr, int item, int lane) {
    const int nblk = N / 32, kb = item / nblk, nb = item % nblk, k0 = 64 * kb, n0 = 32 * nb;
    const int drow0 = mode == 0 ? n0 : ((n0 >> 7) * 256 + (mode == 2 ? 128 : 0) + (n0 & 127));
#pragma unroll 8
    for (int i = 0; i < 32; ++i) { const int kk = 2 * i + (lane >> 5); scr[kk * 33 + (lane & 31)] = W[(size_t)(k0 + kk) * N + n0 + (lane & 31)]; }
    LDS_WAIT(); asm volatile("" ::: "memory");
    const int c = lane & 7;
#pragma unroll
    for (int j = 0; j < 4; ++j) { const int n = (lane >> 3) + 8 * j; const LAS float* s = scr + (8 * c) * 33 + n;
        v4u o; o.x = pk2(s[0 * 33], s[1 * 33]); o.y = pk2(s[2 * 33], s[3 * 33]); o.z = pk2(s[4 * 33], s[5 * 33]); o.w = pk2(s[6 * 33], s[7 * 33]);
        *(GAS v4u*)(WT + (size_t)(drow0 + n) * K + k0 + 8 * c) = o; }
    LDS_WAIT(); asm volatile("" ::: "memory");
}
__device__ __forceinline__ void p0_ada_item(const float* c_lat, const float* c_ctx, const float* w_ada, float* part, LAS float* scr, int item, int lane) {
    const int cc = item % 72, ks = item / 72, k0 = ks * ADA_ROWS;
    for (int idx = lane; idx < NSET * ADA_ROWS; idx += 64) { const int j = idx / ADA_ROWS, kk = idx % ADA_ROWS;
        const float cv = j == 0 ? c_ctx[k0 + kk] : c_lat[(size_t)(j - 1) * DM + k0 + kk];
        scr[idx] = cv / (1.0f + __expf(-cv)); }
    LDS_WAIT(); asm volatile("" ::: "memory");
    f32x4 acc[NSET];
#pragma unroll
    for (int j = 0; j < NSET; ++j) acc[j] = (f32x4){0.f, 0.f, 0.f, 0.f};
    const float* wp = w_ada + (size_t)k0 * NADA + cc * 256 + lane * 4;
#pragma unroll 2
    for (int k4 = 0; k4 < ADA_ROWS; k4 += 4) {
        f32x4 w[4];
#pragma unroll
        for (int i = 0; i < 4; ++i) w[i] = __builtin_nontemporal_load((const f32x4*)(wp + (size_t)(k4 + i) * NADA));
#pragma unroll
        for (int j = 0; j < NSET; ++j) { const f32x4 s = *(const LAS f32x4*)(scr + j * ADA_ROWS + k4);
            acc[j] += w[0] * s[0]; acc[j] += w[1] * s[1]; acc[j] += w[2] * s[2]; acc[j] += w[3] * s[3]; }
    }
#pragma unroll
    for (int j = 0; j < NSET; ++j) *(f32x4*)(part + ((size_t)(ks * NSET + j)) * NADA + cc * 256 + lane * 4) = acc[j];
    LDS_WAIT(); asm volatile("" ::: "memory");
}

__device__ __forceinline__ void rownorm_mod_row(const float* xrow, const float* A, const float* B, bf16* orow, int lane) {
    const GAS f32x4* xr = (const GAS f32x4*)xrow + lane;
    f32x4 v[8]; float s = 0.f;
#pragma unroll
    for (int j = 0; j < 8; ++j) { v[j] = xr[64 * j]; s += (v[j].x * v[j].x + v[j].y * v[j].y) + (v[j].z * v[j].z + v[j].w * v[j].w); }
    const float rstd = 1.0f / sqrtf(wave_sum(s) * (1.0f / DM) + EPS);
    GAS unsigned long long* o8 = (GAS unsigned long long*)orow + lane;
#pragma unroll
    for (int j = 0; j < 8; ++j) { const f32x4 a = *((const f32x4*)A + lane + 64 * j), b = *((const f32x4*)B + lane + 64 * j);
        const f32x4 y = v[j] * rstd * a + b;
        o8[64 * j] = (unsigned long long)pg8::cvt_pk_bf16(y.x, y.y) | ((unsigned long long)pg8::cvt_pk_bf16(y.z, y.w) << 32); }
}

typedef float f32x16 __attribute__((ext_vector_type(16)));
typedef short s16x4 __attribute__((ext_vector_type(4)));
__device__ __forceinline__ int crow(int r, int hi) { return (r & 3) + 8 * (r >> 2) + 4 * hi; }
__device__ __forceinline__ s16x4 vtr(const LAS unsigned char* p) { return __builtin_bit_cast(s16x4, __builtin_amdgcn_ds_read_tr16_b64_v4i16((LAS s16x4*)p)); }
constexpr int AT_K = 0, AT_V = 16384, AT_WS = 32768, AT_TB = 32768 + 2048, AT_END = AT_TB + 2048;
struct AttnArgs { const bf16* qb; const bf16* kb; const bf16* vb; const bf16* ckb; const bf16* cvb; bf16* mixb; const float* rpb; };

__device__ __forceinline__ void attn_unit(LAS unsigned char* lds, const AttnArgs& T, bool lat, int b, int h, int rb) {
    const int tid = threadIdx.x, lane = tid & 63, r32 = lane & 31, hi = lane >> 5; const int wid = __builtin_amdgcn_readfirstlane(tid >> 6);
    int nA, nB, gr0 = 0, rq = 0, c0 = 0, rs = 0; const bf16 *KA, *VA; size_t rowA, rowB = 0, qrow;
    if (lat) { rq = 4 * rb + (wid >> 1); c0 = (wid & 1) * 32; rs = min(max(rq - 4, 0), 24);
        const int rs_min = min(max(4 * rb - 4, 0), 24), rs_max = min(max(4 * rb - 1, 0), 24); nB = rs_max + 8 - rs_min; gr0 = rs_min;
        nA = 8; KA = T.ckb; VA = T.cvb; rowA = (size_t)b * 512; rowB = (size_t)MCTX + (size_t)b * 2048 + 64 * rs_min; qrow = (size_t)MCTX + (size_t)b * 2048 + rq * 64 + c0; }
    else { nA = 4; nB = 0; KA = T.kb; VA = T.vb; rowA = (size_t)b * 256; qrow = (size_t)b * 256 + wid * 32; }
    const int NT = nA + nB;
    __syncthreads();
    if (lat && tid < 480) { const int e = tid & 31, dri = tid >> 5; ((LAS float*)(lds + AT_TB))[tid] = e < 31 ? T.rpb[h * 465 + dri * 31 + e] * LOG2E_F : 0.f; }
    bf16x8 qr[4];
#pragma unroll
    for (int d0 = 0; d0 < 4; ++d0) qr[d0] = *(const bf16x8*)(T.qb + (qrow + r32) * WA + h * 64 + d0 * 16 + hi * 8);
    LAS float* wsf = (LAS float*)(lds + AT_WS) + wid * 64;
    f32x16 o[2]; o[0] = (f32x16){}; o[1] = (f32x16){};
    float m_run = -INFINITY, l_run = 0.f;
    v4u kreg, vreg;
#define AT_LOAD(t) do { const bf16* Kp_; const bf16* Vp_; size_t row_; if ((t) < nA) { Kp_ = KA; Vp_ = VA; row_ = rowA + 64 * (size_t)(t); } else { Kp_ = T.kb; Vp_ = T.vb; row_ = rowB + 64 * (size_t)((t) - nA); } \
        kreg = *(const v4u*)(Kp_ + (row_ + lane) * WA + h * 64 + wid * 8); \
        vreg = *(const v4u*)(Vp_ + (row_ + 16 * (wid & 3) + (lane >> 2)) * WA + h * 64 + (wid >> 2) * 32 + (lane & 3) * 8); } while (0)
    AT_LOAD(0);
    for (int t = 0; t < NT; ++t) {
        const int slot = (t & 1) * 8192;
        *(LAS v4u*)(lds + AT_K + slot + wid * 1024 + lane * 16) = kreg;
        *(LAS v4u*)(lds + AT_V + slot + wid * 1024 + lane * 16) = vreg;
        __syncthreads();
        if (t + 1 < NT) AT_LOAD(t + 1);
        const bool local = t >= nA; const int gr = gr0 + (t - nA);
        if (local && (gr < rs || gr >= rs + 8)) continue;
        f32x16 p0, p1;
        if (local) {
            const LAS float* tb = (const LAS float*)(lds + AT_TB) + (gr - rq + 7) * 32;
            const int c = c0 + r32, cs = min(max(c - 8, 0), 48);
#pragma unroll
            for (int r = 0; r < 16; ++r) { const int kc = crow(r, hi), d = kc - c + 15;
                const bool ok0 = kc >= cs && kc < cs + 16, ok1 = kc + 32 >= cs && kc + 32 < cs + 16;
                const float b0 = tb[min(max(d, 0), 31)], b1 = tb[min(max(d + 32, 0), 31)];
                p0[r] = ok0 ? b0 : -1e30f; p1[r] = ok1 ? b1 : -1e30f; }
        } else { p0 = (f32x16){}; p1 = (f32x16){}; }
        const LAS unsigned char* kbp = lds + AT_K + slot + hi * 1024 + r32 * 16;
#pragma unroll
        for (int d0 = 0; d0 < 4; ++d0) { const bf16x8 k0 = *(const LAS bf16x8*)(kbp + d0 * 2048), k1 = *(const LAS bf16x8*)(kbp + d0 * 2048 + 512);
            p0 = __builtin_amdgcn_mfma_f32_32x32x16_bf16(k0, qr[d0], p0, 0, 0, 0); p1 = __builtin_amdgcn_mfma_f32_32x32x16_bf16(k1, qr[d0], p1, 0, 0, 0); }
        float mx = fmaxf(p0[0], p1[0]);
#pragma unroll
        for (int r = 1; r < 16; ++r) mx = fmaxf(mx, fmaxf(p0[r], p1[r]));
        mx = fmaxf(mx, __shfl_xor(mx, 32));
        const float m_new = fmaxf(m_run, mx);
        if (__any(m_new > m_run)) {
            const float alpha = __builtin_amdgcn_exp2f(m_run - m_new);
            l_run *= alpha; m_run = m_new;
            if (hi == 0) wsf[r32] = alpha;
            LDS_WAIT(); asm volatile("" ::: "memory");
#pragma unroll
            for (int g = 0; g < 4; ++g) { const f32x4 af = *(const LAS f32x4*)(wsf + 8 * g + 4 * hi);
#pragma unroll
                for (int i = 0; i < 4; ++i) { o[0][4 * g + i] *= af[i]; o[1][4 * g + i] *= af[i]; } }
        }
        float ls = 0.f;
#pragma unroll
        for (int r = 0; r < 16; ++r) { p0[r] = __builtin_amdgcn_exp2f(p0[r] - m_run); p1[r] = __builtin_amdgcn_exp2f(p1[r] - m_run); ls += p0[r] + p1[r]; }
        l_run += ls;
        v4u pw[4];
#pragma unroll
        for (int s = 0; s < 2; ++s) {
            pw[s] = (v4u){pg8::cvt_pk_bf16(p0[8 * s], p0[8 * s + 1]), pg8::cvt_pk_bf16(p0[8 * s + 2], p0[8 * s + 3]), pg8::cvt_pk_bf16(p0[8 * s + 4], p0[8 * s + 5]), pg8::cvt_pk_bf16(p0[8 * s + 6], p0[8 * s + 7])};
            pw[2 + s] = (v4u){pg8::cvt_pk_bf16(p1[8 * s], p1[8 * s + 1]), pg8::cvt_pk_bf16(p1[8 * s + 2], p1[8 * s + 3]), pg8::cvt_pk_bf16(p1[8 * s + 4], p1[8 * s + 5]), pg8::cvt_pk_bf16(p1[8 * s + 6], p1[8 * s + 7])}; }
        const LAS unsigned char* vbp = lds + AT_V + slot + ((lane >> 4) & 1) * 32 + (lane & 3) * 8 + (4 * hi + ((lane & 15) >> 2)) * 64;
#pragma unroll
        for (int d0 = 0; d0 < 2; ++d0)
#pragma unroll
            for (int ks = 0; ks < 4; ++ks) { const s16x4 lo = vtr(vbp + d0 * 4096 + ks * 1024), hh = vtr(vbp + d0 * 4096 + ks * 1024 + 512);
                const bf16x8 vf = (bf16x8){lo[0], lo[1], lo[2], lo[3], hh[0], hh[1], hh[2], hh[3]};
                o[d0] = __builtin_amdgcn_mfma_f32_32x32x16_bf16(__builtin_bit_cast(bf16x8, pw[ks]), vf, o[d0], 0, 0, 0); }
    }
#undef AT_LOAD
    l_run += __shfl_xor(l_run, 32);
    if (hi == 0) wsf[r32] = 1.0f / l_run;
    LDS_WAIT(); asm volatile("" ::: "memory");
    bf16* Ow = T.mixb + qrow * DM + h * 64 + r32;
#pragma unroll
    for (int g = 0; g < 4; ++g) { const f32x4 af = *(const LAS f32x4*)(wsf + 8 * g + 4 * hi);
#pragma unroll
        for (int i = 0; i < 4; ++i) { const int q = 8 * g + 4 * hi + i;
            Ow[(size_t)q * DM] = (bf16)f2bf(o[0][4 * g + i] * af[i]); Ow[(size_t)q * DM + 32] = (bf16)f2bf(o[1][4 * g + i] * af[i]); } }
}

struct GateArgs { const bf16* ub; const bf16* vgb; const float* w_s; const float* b_s; const float* gnorm; bf16* mixb; };
__device__ __forceinline__ void gate_unit(LAS unsigned char* lds, const GateArgs& T, int n, int g) {
    const int tid = threadIdx.x, lane = tid & 63, r32 = lane & 31, hi = lane >> 5; const int wid = __builtin_amdgcn_readfirstlane(tid >> 6);
    const size_t row0 = (size_t)n * 128;
    __syncthreads();
#pragma unroll
    for (int i = 0; i < 4; ++i) { const int ci = tid + 512 * i, row = ci >> 4, ch = ci & 15;
        const v4u raw = *(const v4u*)(T.vgb + (row0 + row) * WA + g * 128 + ch * 8);
        float v[8]; v[0] = bflo(raw.x); v[1] = bfhi(raw.x); v[2] = bflo(raw.y); v[3] = bfhi(raw.y); v[4] = bflo(raw.z); v[5] = bfhi(raw.z); v[6] = bflo(raw.w); v[7] = bfhi(raw.w);
        float ss = 0.f;
#pragma unroll
        for (int e = 0; e < 8; ++e) ss += v[e] * v[e];
        ss += __shfl_xor(ss, 1); ss += __shfl_xor(ss, 2); ss += __shfl_xor(ss, 4); ss += __shfl_xor(ss, 8);
        const float rstd = 1.0f / sqrtf(ss * (1.0f / 128.0f) + EPS);
        const f32x4 g0 = *(const f32x4*)(T.gnorm + g * 128 + ch * 8), g1 = *(const f32x4*)(T.gnorm + g * 128 + ch * 8 + 4);
        v4u w; w.x = pg8::cvt_pk_bf16(v[0] * rstd * g0[0], v[1] * rstd * g0[1]); w.y = pg8::cvt_pk_bf16(v[2] * rstd * g0[2], v[3] * rstd * g0[3]);
        w.z = pg8::cvt_pk_bf16(v[4] * rstd * g1[0], v[5] * rstd * g1[1]); w.w = pg8::cvt_pk_bf16(v[6] * rstd * g1[2], v[7] * rstd * g1[3]);
        *(LAS v4u*)(lds + (ch >> 2) * 8192 + row * 64 + (ch & 3) * 16) = w; }
    __syncthreads();
    const int ib = wid >> 1, cb0 = 2 * (wid & 1);
    f32x16 acc[2]; acc[0] = (f32x16){}; acc[1] = (f32x16){};
    const float* wrow = T.w_s + ((size_t)g * 128 + 32 * ib + r32) * 128 + 4 * hi;
    const LAS unsigned char* vbp = lds + ((lane >> 4) & 1) * 32 + (lane & 3) * 8 + (4 * hi + ((lane & 15) >> 2)) * 64;
#pragma unroll
    for (int ks = 0; ks < 8; ++ks) {
        const f32x4 a0 = *(const f32x4*)(wrow + 16 * ks), a1 = *(const f32x4*)(wrow + 16 * ks + 8);
        const v4u aw = (v4u){pg8::cvt_pk_bf16(a0[0], a0[1]), pg8::cvt_pk_bf16(a0[2], a0[3]), pg8::cvt_pk_bf16(a1[0], a1[1]), pg8::cvt_pk_bf16(a1[2], a1[3])};
#pragma unroll
        for (int cbi = 0; cbi < 2; ++cbi) { const LAS unsigned char* p = vbp + (cb0 + cbi) * 8192 + ks * 1024;
            const s16x4 lo = vtr(p), hh = vtr(p + 512);
            const bf16x8 vf = (bf16x8){lo[0], lo[1], lo[2], lo[3], hh[0], hh[1], hh[2], hh[3]};
            acc[cbi] = __builtin_amdgcn_mfma_f32_32x32x16_bf16(__builtin_bit_cast(bf16x8, aw), vf, acc[cbi], 0, 0, 0); }
    }
#pragma unroll
    for (int cbi = 0; cbi < 2; ++cbi)
#pragma unroll
        for (int r = 0; r < 16; ++r) { const int i = 32 * ib + crow(r, hi), c = g * 128 + 32 * (cb0 + cbi) + r32;
            const float s = acc[cbi][r] + T.b_s[g * 128 + i];
            const float uu = bf2f(T.ub[(row0 + i) * WA + c]);
            T.mixb[(row0 + i) * DM + WA + c] = (bf16)f2bf(uu * s); }
}

struct Args { const float* in[26]; float* out; unsigned char* ws; int ph_lo, ph_hi, li, pad; };
constexpr int N_PHASES = 14;
__global__ void __launch_bounds__(NWAVES * 64, 2) mega_fwd(Args args) {
    extern __shared__ __attribute__((aligned(16))) unsigned char lds[];
    Frame F;
    F.lds = (LAS unsigned char*)lds;
    F.MISC = (volatile LAS unsigned*)(F.lds + MISC_OFF);
    F.tid = threadIdx.x; F.lane = F.tid & 63; F.wave = __builtin_amdgcn_readfirstlane(F.tid >> 6);
    F.G = gridDim.x; { const int bx = blockIdx.x; F.vcu = (F.G % 8 == 0) ? (bx % 8) * (F.G / 8) + bx / 8 : bx; }
    unsigned char* ws = args.ws;
    F.ctl = (gu32*)(ws + WS_CTL);
    const float* x_prompt = args.in[0]; const float* x_sample = args.in[1];
    float* const xbuf = args.out;
    float* const state_k = args.out + (size_t)MTOK * DM; float* const state_v = state_k + (size_t)MCTX * WA;
    bf16* const Wgu1 = (bf16*)(ws + WS_WGU1); bf16* const Wd1 = (bf16*)(ws + WS_WD1); bf16* const Win = (bf16*)(ws + WS_WIN); bf16* const Wout = (bf16*)(ws + WS_WOUT);
    bf16* const Wgu2 = (bf16*)(ws + WS_WGU2); bf16* const Wd2 = (bf16*)(ws + WS_WD2);
    bf16* const HB = (bf16*)(ws + WS_H); bf16* const ACT = (bf16*)(ws + WS_ACT);
    bf16* const QB = (bf16*)(ws + WS_Q); bf16* const KB = (bf16*)(ws + WS_K); bf16* const VB = (bf16*)(ws + WS_V); bf16* const UB = (bf16*)(ws + WS_U); bf16* const VGB = (bf16*)(ws + WS_VG);
    bf16* const MIXB = (bf16*)(ws + WS_MIX); bf16* const CKB = (bf16*)(ws + WS_CK); bf16* const CVB = (bf16*)(ws + WS_CV);
    float* const MODP = (float*)(ws + WS_MODP); float* const MOD = (float*)(ws + WS_MOD);

    for (int u = F.tid; u < (LDS_BYTES - LDSCTL_OFF) / 4; u += NWAVES * 64) ((LAS unsigned*)(F.lds + LDSCTL_OFF))[u] = 0u;
    __syncthreads();
    XcdBarrier bar = xcd_barrier_post((unsigned*)(F.ctl + CW_BAR) + args.li * XCD_BAR_WORDS, F.MISC + 8);
    const int lo = args.ph_lo, hi = args.ph_hi;
#define IN(k) (lo <= (k) && (k) < hi)
#define SEAM(k) do { if (IN(k) && IN((k) + 1)) xcd_barrier(bar); } while (0)
    const int gw = F.vcu * NWAVES + F.wave, NGW = F.G * NWAVES;

    if (IN(0)) {
        LAS float* scr = (LAS float*)(F.lds + RING_OFF + F.wave * 16384);
        { const int gt = F.vcu * (NWAVES * 64) + F.tid, NGT = F.G * NWAVES * 64;
          for (int i = gt; i < 2 * 262144; i += NGT) { const int which = i >= 262144, e = (which ? i - 262144 : i) * 8; const float* src = args.in[2 + which] + e;
              const f32x4 a = *(const f32x4*)src, b2 = *(const f32x4*)(src + 4);
              v4u o; o.x = pg8::cvt_pk_bf16(a[0], a[1]); o.y = pg8::cvt_pk_bf16(a[2], a[3]); o.z = pg8::cvt_pk_bf16(b2[0], b2[1]); o.w = pg8::cvt_pk_bf16(b2[2], b2[3]);
              *(v4u*)((which ? CVB : CKB) + e) = o; } }
        constexpr int I_GU = 32 * 176, I_D = 88 * 64, I_IN = 32 * 160, I_OUT = 32 * 64;
        constexpr int NTR = 6 * I_GU + I_IN + I_OUT;
        static_assert(I_GU == I_D && NTR == 40960, "item count");
        int t0, t1;
        if (NGW == 2048) { if (gw < 1152) { p0_ada_item(args.in[4], args.in[5], args.in[6], MODP, scr, gw, F.lane); t0 = gw * 13; t1 = t0 + 13; } else { t0 = 14976 + (gw - 1152) * 29; t1 = t0 + 29; } }
        else { for (int it = gw; it < 1152; it += NGW) p0_ada_item(args.in[4], args.in[5], args.in[6], MODP, scr, it, F.lane); const int per = (NTR + NGW - 1) / NGW; t0 = gw * per; t1 = min(t0 + per, NTR); }
        for (int it = t0; it < t1; ++it) {
            int r = it;
            if (r < I_GU) { p0_transpose_item(args.in[9], DM, DFF, Wgu1, 1, scr, r, F.lane); continue; } r -= I_GU;
            if (r < I_GU) { p0_transpose_item(args.in[10], DM, DFF, Wgu1, 2, scr, r, F.lane); continue; } r -= I_GU;
            if (r < I_D) { p0_transpose_item(args.in[11], DFF, DM, Wd1, 0, scr, r, F.lane); continue; } r -= I_D;
            if (r < I_IN) { p0_transpose_item(args.in[13], DM, INW, Win, 0, scr, r, F.lane); continue; } r -= I_IN;
            if (r < I_OUT) { p0_transpose_item(args.in[20], DM, DM, Wout, 0, scr, r, F.lane); continue; } r -= I_OUT;
            if (r < I_GU) { p0_transpose_item(args.in[22], DM, DFF, Wgu2, 1, scr, r, F.lane); continue; } r -= I_GU;
            if (r < I_GU) { p0_transpose_item(args.in[23], DM, DFF, Wgu2, 2, scr, r, F.lane); continue; } r -= I_GU;
            p0_transpose_item(args.in[24], DFF, DM, Wd2, 0, scr, r, F.lane);
        }
    }
    SEAM(0);
    if (IN(1)) {
        const int gt = F.vcu * (NWAVES * 64) + F.tid, NGT = F.G * NWAVES * 64;
        for (int idx = gt; idx < NSET * NADA; idx += NGT) { const int j = idx / NADA, n = idx % NADA, chunk = n >> 11, col = n & 2047;
            float s = args.in[7][n];
#pragma unroll
            for (int ks = 0; ks < KSPLIT_ADA; ++ks) s += MODP[((size_t)(ks * NSET + j)) * NADA + n];
            const int sub = chunk / 3, kind = chunk % 3;
            if (kind == 1) { const float* gn = sub == 0 ? args.in[8] : sub == 1 ? args.in[12] : args.in[21]; s = gn[col] * (1.0f + s); }
            else if (kind == 2 && sub != 1) s *= 0.5f;
            MOD[(size_t)j * NADA + n] = s; }
    }
    SEAM(1);
    if (IN(2)) {
        for (int m = gw; m < MTOK; m += NGW) { const int j = m < MCTX ? 0 : 1 + ((m - MCTX) >> 11);
            const float* xr = m < MCTX ? x_prompt + (size_t)m * DM : x_sample + (size_t)(m - MCTX) * DM;
            rownorm_mod_row(xr, MOD + (size_t)j * NADA + 1 * DM, MOD + (size_t)j * NADA + 0 * DM, HB + (size_t)m * DM, F.lane); }
    }
    SEAM(2);
    if (IN(3)) {
        pg8::Gemm g{HB, Wgu1, MTOK, 2 * DFF, DM}; pg8::StaticOrder S; S.init(MTOK, 2 * DFF, F.G, (int)blockIdx.x);
        pg8::EpiSwiGLU E{ACT, DFF};
        pg8::gemm_phase<pg8::EpiSwiGLU, pg8::StaticOrder, true, true>(F.lds + RING_OFF, g, S, E);
    }
    SEAM(3);
    if (IN(4)) {
        pg8::Gemm g{ACT, Wd1, MTOK, DM, DFF}; pg8::StaticOrder S; S.init(MTOK, DM, F.G, (int)blockIdx.x);
        pg8::EpiRes E{x_prompt, x_sample, xbuf, MOD + 2 * DM, DM};
        pg8::gemm_phase<pg8::EpiRes, pg8::StaticOrder, true, true>(F.lds + RING_OFF, g, S, E);
    }
    SEAM(4);
    if (IN(5)) {
        for (int m = gw; m < MTOK; m += NGW) { const int j = m < MCTX ? 0 : 1 + ((m - MCTX) >> 11);
            rownorm_mod_row(xbuf + (size_t)m * DM, MOD + (size_t)j * NADA + 4 * DM, MOD + (size_t)j * NADA + 3 * DM, HB + (size_t)m * DM, F.lane); }
    }
    SEAM(5);
    if (IN(6)) {
        pg8::Gemm g{HB, Win, MTOK, INW, DM}; pg8::StaticOrder S; S.init(MTOK, INW, F.G, (int)blockIdx.x);
        pg8::EpiMixIn E{QB, KB, VB, UB, VGB, state_k, state_v, 0.125f * LOG2E_F};
        pg8::gemm_phase<pg8::EpiMixIn, pg8::StaticOrder, true, true>(F.lds + RING_OFF, g, S, E);
    }
    SEAM(6);
    if (IN(7)) {
        const AttnArgs AT{QB, KB, VB, CKB, CVB, MIXB, args.in[14]};
        const GateArgs GT{UB, VGB, args.in[16], args.in[17], args.in[15], MIXB};
        for (int u = F.vcu; u < 512; u += F.G) attn_unit(F.lds + RING_OFF, AT, true, u >> 7, (u >> 3) & 15, u & 7);
        for (int u = F.vcu; u < 256; u += F.G) attn_unit(F.lds + RING_OFF, AT, false, u >> 4, u & 15, 0);
        for (int u = F.vcu; u < 768; u += F.G) gate_unit(F.lds + RING_OFF, GT, u >> 3, u & 7);
    }
    SEAM(7);
    if (IN(8)) {
        for (int m = gw; m < MTOK; m += NGW) {
            v4u* rowp = (v4u*)(MIXB + (size_t)m * DM) + F.lane;
#pragma unroll
            for (int half = 0; half < 2; ++half) {
                v4u raw[2]; float v[16]; float ss = 0.f;
#pragma unroll
                for (int j = 0; j < 2; ++j) { raw[j] = rowp[half * 128 + 64 * j];
                    v[8 * j + 0] = bflo(raw[j].x); v[8 * j + 1] = bfhi(raw[j].x); v[8 * j + 2] = bflo(raw[j].y); v[8 * j + 3] = bfhi(raw[j].y);
                    v[8 * j + 4] = bflo(raw[j].z); v[8 * j + 5] = bfhi(raw[j].z); v[8 * j + 6] = bflo(raw[j].w); v[8 * j + 7] = bfhi(raw[j].w); }
#pragma unroll
                for (int e = 0; e < 16; ++e) ss += v[e] * v[e];
                const float rstd = 1.0f / sqrtf(wave_sum(ss) * (1.0f / WA) + EPS);
                const float* gn = args.in[18 + half];
#pragma unroll
                for (int j = 0; j < 2; ++j) { const f32x4 g0 = *(const f32x4*)(gn + (F.lane + 64 * j) * 8), g1 = *(const f32x4*)(gn + (F.lane + 64 * j) * 8 + 4);
                    v4u w; w.x = pg8::cvt_pk_bf16(v[8 * j + 0] * rstd * g0[0], v[8 * j + 1] * rstd * g0[1]); w.y = pg8::cvt_pk_bf16(v[8 * j + 2] * rstd * g0[2], v[8 * j + 3] * rstd * g0[3]);
                    w.z = pg8::cvt_pk_bf16(v[8 * j + 4] * rstd * g1[0], v[8 * j + 5] * rstd * g1[1]); w.w = pg8::cvt_pk_bf16(v[8 * j + 6] * rstd * g1[2], v[8 * j + 7] * rstd * g1[3]);
                    rowp[half * 128 + 64 * j] = w; }
            }
        }
    }
    SEAM(8);
    if (IN(9)) {
        pg8::Gemm g{MIXB, Wout, MTOK, DM, DM}; pg8::StaticOrder S; S.init(MTOK, DM, F.G, (int)blockIdx.x);
        pg8::EpiRes E{xbuf, xbuf + (size_t)MCTX * DM, xbuf, MOD + 5 * DM, DM};
        pg8::gemm_phase<pg8::EpiRes, pg8::StaticOrder, true, true>(F.lds + RING_OFF, g, S, E);
    }
    SEAM(9);
    if (IN(10)) {
        for (int m = gw; m < MTOK; m += NGW) { const int j = m < MCTX ? 0 : 1 + ((m - MCTX) >> 11);
            rownorm_mod_row(xbuf + (size_t)m * DM, MOD + (size_t)j * NADA + 7 * DM, MOD + (size_t)j * NADA + 6 * DM, HB + (size_t)m * DM, F.lane); }
    }
    SEAM(10);
    if (IN(11)) {
        pg8::Gemm g{HB, Wgu2, MTOK, 2 * DFF, DM}; pg8::StaticOrder S; S.init(MTOK, 2 * DFF, F.G, (int)blockIdx.x);
        pg8::EpiSwiGLU E{ACT, DFF};
        pg8::gemm_phase<pg8::EpiSwiGLU, pg8::StaticOrder, true, true>(F.lds + RING_OFF, g, S, E);
    }
    SEAM(11);
    if (IN(12)) {
        pg8::Gemm g{ACT, Wd2, MTOK, DM, DFF}; pg8::StaticOrder S; S.init(MTOK, DM, F.G, (int)blockIdx.x);
        pg8::EpiRes E{xbuf, xbuf + (size_t)MCTX * DM, xbuf, MOD + 8 * DM, DM};
        pg8::gemm_phase<pg8::EpiRes, pg8::StaticOrder, true, true>(F.lds + RING_OFF, g, S, E);
    }
    SEAM(12);
    if (IN(13)) {
        const float* fg = args.in[25];
        for (int m = gw; m < MTOK; m += NGW) {
            GAS f32x4* xr = (GAS f32x4*)(xbuf + (size_t)m * DM) + F.lane;
            f32x4 v[8]; float s = 0.f;
#pragma unroll
            for (int j = 0; j < 8; ++j) { v[j] = xr[64 * j]; s += (v[j].x * v[j].x + v[j].y * v[j].y) + (v[j].z * v[j].z + v[j].w * v[j].w); }
            const float rstd = 1.0f / sqrtf(wave_sum(s) * (1.0f / DM) + EPS);
#pragma unroll
            for (int j = 0; j < 8; ++j) xr[64 * j] = v[j] * rstd * *((const f32x4*)fg + F.lane + 64 * j);
        }
    }
#undef IN
#undef SEAM
}

#ifndef MK_N_LAUNCHES
#define MK_N_LAUNCHES 1
#endif
extern "C" void kernel_launch(void* const* d_in, const int* in_sizes, int n_in, void* d_out, int out_size, void* d_ws, size_t ws_size, hipStream_t stream) {
    static int grid = 0;
    if (grid == 0) {
        if (n_in != 26 || out_size != MTOK * DM + 2 * MCTX * WA || ws_size < WS_END) { fprintf(stderr, "kernel_launch: unexpected shapes: n_in %d out %d ws %zu (need %zu); nothing launched\n", n_in, out_size, ws_size, (size_t)WS_END); grid = -1; return; }
        int dev = 0, cus = 0, per_cu = 0;
        if (hipGetDevice(&dev) != hipSuccess || hipDeviceGetAttribute(&cus, hipDeviceAttributeMultiprocessorCount, dev) != hipSuccess) { fprintf(stderr, "kernel_launch: device query failed\n"); grid = -1; return; }
        if (hipFuncSetAttribute((const void*)mega_fwd, hipFuncAttributeMaxDynamicSharedMemorySize, LDS_BYTES) != hipSuccess) { fprintf(stderr, "kernel_launch: hipFuncSetAttribute failed\n"); grid = -1; return; }
        if (hipOccupancyMaxActiveBlocksPerMultiprocessor(&per_cu, (const void*)mega_fwd, NWAVES * 64, LDS_BYTES) != hipSuccess || per_cu < 1)
            fprintf(stderr, "kernel_launch: note: occupancy query reports %d workgroups per CU\n", per_cu);
        (void)hipGetLastError();
        grid = cus;
    }
    if (grid < 0) return;
    if (hipMemsetAsync((char*)d_ws + WS_CTL, 0, CTL_ZERO_BYTES, stream) != hipSuccess) { fprintf(stderr, "kernel_launch: hipMemsetAsync failed\n"); return; }
    Args a{};
    for (int i = 0; i < 26; ++i) a.in[i] = (const float*)d_in[i];
    a.out = (float*)d_out; a.ws = (unsigned char*)d_ws;
    if (MK_N_LAUNCHES == 1) { a.ph_lo = 0; a.ph_hi = N_PHASES; a.li = 0; hipLaunchKernelGGL(mega_fwd, dim3(grid), dim3(NWAVES * 64), LDS_BYTES, stream, a); }
    else { for (int p = 0; p < N_PHASES; ++p) { a.ph_lo = p; a.ph_hi = p + 1; a.li = 0; hipLaunchKernelGGL(mega_fwd, dim3(grid), dim3(NWAVES * 64), LDS_BYTES, stream, a); } }
    const hipError_t le = hipPeekAtLastError();
    if (le != hipSuccess) fprintf(stderr, "kernel_launch: launch failed: %s\n", hipGetErrorName(le));
}
```

```cpp
#include <hip/hip_runtime.h>
#include <cstdio>
#include <cstdint>
namespace pg8 {
#define PG8_LAS __attribute__((address_space(3)))
typedef unsigned short bf16_t;
typedef short bf16x8 __attribute__((ext_vector_type(8)));
typedef float f32x4 __attribute__((ext_vector_type(4)));
typedef unsigned u32x4 __attribute__((ext_vector_type(4)));
typedef int i32x4 __attribute__((ext_vector_type(4)));
typedef int i32x8 __attribute__((ext_vector_type(8)));
constexpr int BM = 256, BK = 64, HALF = 128, HTB = HALF * BK * 2  , STAGE_BYTES = 8 * HTB, NXCD = 8, WGM = 8;

__host__ __device__ __forceinline__ int lds_byte(int r, int c) { const int st = (r >> 4) * 2 + (c >> 5), rr = r & 15, cc = c & 31, ob = rr * 64 + cc * 2; return st * 1024 + (ob ^ (((ob >> 9) & 1) << 5)); }
__host__ __device__ __forceinline__ void stage_rc(int b, int& R, int& C) { const int st = b / 1024, sb = b % 1024, swz = sb ^ (((sb >> 9) & 1) << 5); R = (st >> 1) * 16 + swz / 64; C = (st & 1) * 32 + (swz % 64) / 2; }
__host__ __device__ __forceinline__ int perm32(int rho) { const int n = rho >> 4, i = rho & 15; return 8 * (i >> 2) + 4 * n + (i & 3); }

struct Unit { int pm, pn; };
struct Gemm { const bf16_t* A; const bf16_t* Bt; int M, N, K; };

struct StaticOrder {
    int nM, nN, nwg, G, c;
    __host__ __device__ void init(int M, int N, int G_, int c_) { nM = M / BM; nN = N / BM; nwg = nM * nN; G = G_; c = c_; }
    __host__ __device__ bool next(int i, Unit& u) const {
        const long L = (long)i * G + c; if (L >= nwg) return false;
        int wgid = (int)L; { const int q = nwg / NXCD, r = nwg % NXCD, xcd = wgid % NXCD, off = wgid / NXCD; wgid = (xcd < r ? xcd * (q + 1) : r * (q + 1) + (xcd - r) * q) + off; }
        const int nig = WGM * nN, gid = wgid / nig, fm = gid * WGM, gsz = (nM - fm) < WGM ? (nM - fm) : WGM;
        u.pm = fm + ((wgid % nig) % gsz); u.pn = (wgid % nig) / gsz; return true;
    }
    __device__ __forceinline__ void a_ready(const Unit&) const {}
    __device__ __forceinline__ void done(const Unit&) const {}
};

__device__ __forceinline__ unsigned cvt_pk_bf16(float lo, float hi) { unsigned r; asm volatile("v_cvt_pk_bf16_f32 %0, %1, %2" : "=v"(r) : "v"(lo), "v"(hi)); return r; }
typedef float f32x2 __attribute__((ext_vector_type(2)));
typedef unsigned u32x2 __attribute__((ext_vector_type(2)));
constexpr float LOG2E = 1.4426950408889634f;
__device__ __forceinline__ float silu_f(float g) { return g * __builtin_amdgcn_rcpf(1.0f + __builtin_amdgcn_exp2f(-LOG2E * g)); }
__device__ __forceinline__ float gelu_tanh_f(float x) { const float t = x * (-2.3022081983f + -0.1029432407f * x * x); return x * __builtin_amdgcn_rcpf(1.0f + __builtin_amdgcn_exp2f(t)); }

__device__ __forceinline__ int mod_set_of_tile(int pm) { return pm < 16 ? 0 : 1 + ((pm - 16) >> 3); }
constexpr int MOD_JSTRIDE = 9 * 2048;

__device__ __forceinline__ unsigned pack4_fp8(float a, float b, float c, float d) {
    a = __builtin_fminf(__builtin_fmaxf(a, -448.f), 448.f); b = __builtin_fminf(__builtin_fmaxf(b, -448.f), 448.f);
    c = __builtin_fminf(__builtin_fmaxf(c, -448.f), 448.f); d = __builtin_fminf(__builtin_fmaxf(d, -448.f), 448.f);
    int p = __builtin_amdgcn_cvt_pk_fp8_f32(a, b, 0, false); p = __builtin_amdgcn_cvt_pk_fp8_f32(c, d, p, true); return (unsigned)p;
}
constexpr float F8_SA = 8.0f, F8_SW = 128.0f, F8_DQ = 1.0f / (F8_SA * F8_SW);
struct EpiSwiGLU8 {
    static constexpr bool PERM = true, AFTER_DRAIN = false;
    unsigned char* O; int ldc;
    __device__ __forceinline__ void operator()(const f32x4 (&acc)[2][2][4][2], const Unit& u, int wr, int wc, int fr, int fq) const {
        const int row0 = u.pm * BM + wr * 64 + fr, col0 = u.pn * HALF + wc * 32 + 8 * fq;
#pragma unroll
        for (int ai = 0; ai < 2; ++ai)
#pragma unroll
            for (int m = 0; m < 4; ++m) { unsigned char* rowp = O + (size_t)(row0 + ai * HALF + m * 16) * ldc + col0;
                const f32x4 g0 = acc[ai][0][m][0] * F8_DQ, g1 = acc[ai][0][m][1] * F8_DQ, u0 = acc[ai][1][m][0] * (F8_DQ * F8_SA), u1 = acc[ai][1][m][1] * (F8_DQ * F8_SA);
                u32x2 w; w.x = pack4_fp8(silu_f(g0[0]) * u0[0], silu_f(g0[1]) * u0[1], silu_f(g0[2]) * u0[2], silu_f(g0[3]) * u0[3]);
                w.y = pack4_fp8(silu_f(g1[0]) * u1[0], silu_f(g1[1]) * u1[1], silu_f(g1[2]) * u1[2], silu_f(g1[3]) * u1[3]);
                *(u32x2*)rowp = w; }
    }
};

struct EpiSwiGLU {
    static constexpr bool PERM = true, AFTER_DRAIN = false;
    bf16_t* O; int ldc; int skip;
    __device__ __forceinline__ void operator()(const f32x4 (&acc)[2][2][4][2], const Unit& u, int wr, int wc, int fr, int fq) const {
#if defined(PROBE_NULL_EPI)
        if (skip) {
#pragma unroll
            for (int ai = 0; ai < 2; ++ai)
#pragma unroll
                for (int bj = 0; bj < 2; ++bj)
#pragma unroll
                    for (int m = 0; m < 4; ++m)
#pragma unroll
                        for (int n = 0; n < 2; ++n) asm volatile("" :: "v"(acc[ai][bj][m][n]));
            return; }
#endif
        const int row0 = u.pm * BM + wr * 64 + fr, col0 = u.pn * HALF + wc * 32 + 8 * fq;
#pragma unroll
        for (int ai = 0; ai < 2; ++ai)
#pragma unroll
            for (int m = 0; m < 4; ++m) { bf16_t* rowp = O + (size_t)(row0 + ai * HALF + m * 16) * ldc + col0;
                const f32x4 g0 = acc[ai][0][m][0], g1 = acc[ai][0][m][1], u0 = acc[ai][1][m][0], u1 = acc[ai][1][m][1];
                u32x4 w; w.x = cvt_pk_bf16(silu_f(g0[0]) * u0[0], silu_f(g0[1]) * u0[1]); w.y = cvt_pk_bf16(silu_f(g0[2]) * u0[2], silu_f(g0[3]) * u0[3]);
                w.z = cvt_pk_bf16(silu_f(g1[0]) * u1[0], silu_f(g1[1]) * u1[1]); w.w = cvt_pk_bf16(silu_f(g1[2]) * u1[2], silu_f(g1[3]) * u1[3]);
                *(u32x4*)rowp = w; }
    }
};

struct EpiRes {
    static constexpr bool PERM = false, AFTER_DRAIN = false;
    const float* base_ctx; const float* base_lat; float* out; const float* gtab; int ldc; float dq;
    __device__ __forceinline__ void operator()(const f32x4 (&acc)[2][2][4][2], const Unit& u, int wr, int wc, int fr, int fq) const {
        const int row0 = u.pm * BM + wr * 64 + fr, col0 = u.pn * BM + wc * 32 + 4 * fq;
        const float* gv = gtab + (size_t)mod_set_of_tile(u.pm) * MOD_JSTRIDE;
        const float* bbase = u.pm < 16 ? base_ctx : base_lat; const int brow0 = u.pm < 16 ? row0 : row0 - 4096;
        f32x4 gvv[2][2];
#pragma unroll
        for (int bj = 0; bj < 2; ++bj)
#pragma unroll
            for (int n = 0; n < 2; ++n) gvv[bj][n] = *(const f32x4*)(gv + col0 + bj * HALF + n * 16) * dq;
#pragma unroll
        for (int ai = 0; ai < 2; ++ai)
#pragma unroll
            for (int m = 0; m < 4; ++m) { const size_t boff = (size_t)(brow0 + ai * HALF + m * 16) * ldc + col0, ooff = (size_t)(row0 + ai * HALF + m * 16) * ldc + col0;
#pragma unroll
                for (int bj = 0; bj < 2; ++bj)
#pragma unroll
                    for (int n = 0; n < 2; ++n) { const f32x4 bs = *(const f32x4*)(bbase + boff + bj * HALF + n * 16);
                        *(f32x4*)(out + ooff + bj * HALF + n * 16) = bs + gvv[bj][n] * acc[ai][bj][m][n]; } }
    }
};

struct EpiMixIn {
    static constexpr bool PERM = true, AFTER_DRAIN = false;
    bf16_t* qb; bf16_t* kb; bf16_t* vb; bf16_t* ub; bf16_t* vgb; float* state_k; float* state_v; float qscale;
    __device__ __forceinline__ void operator()(const f32x4 (&acc)[2][2][4][2], const Unit& u, int wr, int wc, int fr, int fq) const {
        const int row0 = u.pm * BM + wr * 64 + fr;
#pragma unroll
        for (int bj = 0; bj < 2; ++bj) {
            const int colg = u.pn * BM + bj * HALF, region = colg >> 10, cb = (colg & 1023) + wc * 32 + 8 * fq;
            bf16_t* dst = region == 0 ? qb : region == 1 ? kb : region == 2 ? vb : region == 3 ? ub : vgb;
            float* st = region == 1 ? state_k : state_v; const bool wst = (region == 1 || region == 2) && u.pm < 16;
#pragma unroll
            for (int ai = 0; ai < 2; ++ai)
#pragma unroll
                for (int m = 0; m < 4; ++m) { const int row = row0 + ai * HALF + m * 16; f32x4 v0 = acc[ai][bj][m][0], v1 = acc[ai][bj][m][1];
                    if (wst) { *(f32x4*)(st + (size_t)row * 1024 + cb) = v0; *(f32x4*)(st + (size_t)row * 1024 + cb + 4) = v1; }
                    if (region == 0) { v0 = v0 * qscale; v1 = v1 * qscale; }
                    if (region >= 3) {
#pragma unroll
                        for (int i = 0; i < 4; ++i) { v0[i] = gelu_tanh_f(v0[i]); v1[i] = gelu_tanh_f(v1[i]); } }
                    u32x4 w; w.x = cvt_pk_bf16(v0[0], v0[1]); w.y = cvt_pk_bf16(v0[2], v0[3]); w.z = cvt_pk_bf16(v1[0], v1[1]); w.w = cvt_pk_bf16(v1[2], v1[3]);
                    *(u32x4*)(dst + (size_t)row * 1024 + cb) = w; }
        }
    }
};

struct EpiNull {
    static constexpr bool PERM = true, AFTER_DRAIN = false;
    __device__ __forceinline__ void operator()(const f32x4 (&acc)[2][2][4][2], const Unit& u, int wr, int wc, int fr, int fq) const {
#pragma unroll
        for (int ai = 0; ai < 2; ++ai)
#pragma unroll
            for (int bj = 0; bj < 2; ++bj)
#pragma unroll
                for (int m = 0; m < 4; ++m)
#pragma unroll
                    for (int n = 0; n < 2; ++n) asm volatile("" :: "v"(acc[ai][bj][m][n]));
    }
};

template <class Epi, class Sched, bool ALIGN_EPI = false, bool SP2 = false, bool F8 = false>
__device__ __forceinline__ void gemm_phase(PG8_LAS unsigned char* lds, const Gemm g, const Sched& S, const Epi& E) {
    const int tid = threadIdx.x, wid = __builtin_amdgcn_readfirstlane(tid >> 6), lane = tid & 63, wr = wid >> 2, wc = wid & 3, fr = lane & 15, fq = lane >> 4;
    const int K = g.K, nt = K / BK;
    unsigned voffA[2], voffB[2];
#pragma unroll
    for (int i = 0; i < 2; ++i) { int R, C; stage_rc(tid * 16 + i * 8192, R, C); const int Rb = Epi::PERM ? ((R & ~31) + perm32(R & 31)) : R;
        voffA[i] = (unsigned)(R * K + C) * 2u; voffB[i] = (unsigned)(Rb * K + C) * 2u; }
    const size_t kstep = (size_t)(BK * 2);
    const size_t hstep = (size_t)HALF * K * 2;
    const size_t tstep = 2 * hstep;
    const unsigned ldsw = (unsigned)wid * 1024u;
    const int aoff = lds_byte(wr * 64 + fr, fq * 8), boff = lds_byte(wc * 32 + fr, fq * 8);
    const int a8 = lds_byte(wr * 64 + fr, fq * 16), b8 = lds_byte(wc * 32 + fr, fq * 16);
    const int aoffk0 = F8 ? a8 + (fq & 1) * 16 : aoff, aoffk1 = F8 ? a8 + ((fq & 1) ^ 1) * 16 : aoff + 1024;
    const int boffk0 = F8 ? b8 + (fq & 1) * 16 : boff, boffk1 = F8 ? b8 + ((fq & 1) ^ 1) * 16 : boff + 1024;
#define PG8_SA(b, h) (((b) * 2 + (h)) * HTB)
#define PG8_SB(b, h) ((4 + (b) * 2 + (h)) * HTB)
#define PG8_STAGE(bufoff, gbase, voff) do { _Pragma("unroll") for (int _i = 0; _i < 2; ++_i) \
        __builtin_amdgcn_global_load_lds((const unsigned*)((const char*)(gbase) + (voff)[_i]), (PG8_LAS unsigned*)(lds + (bufoff) + ldsw + _i * 8192), 16, 0, 0); } while (0)
#define PG8_LDA(dst, b, h) do { _Pragma("unroll") for (int m = 0; m < 4; ++m) { dst[m][0] = *(const PG8_LAS bf16x8*)(lds + PG8_SA(b, h) + aoffk0 + m * 2048); dst[m][1] = *(const PG8_LAS bf16x8*)(lds + PG8_SA(b, h) + aoffk1 + m * 2048); } } while (0)
#define PG8_LDB(dst, b, h) do { _Pragma("unroll") for (int n = 0; n < 2; ++n) { dst[n][0] = *(const PG8_LAS bf16x8*)(lds + PG8_SB(b, h) + boffk0 + n * 2048); dst[n][1] = *(const PG8_LAS bf16x8*)(lds + PG8_SB(b, h) + boffk1 + n * 2048); } } while (0)
#define PG8_CAT8(x) __builtin_shufflevector(__builtin_bit_cast(i32x4, (x)[0]), __builtin_bit_cast(i32x4, (x)[1]), 0, 1, 2, 3, 4, 5, 6, 7)
#define PG8_MMA(ai, bj, At, Bt) do { __builtin_amdgcn_s_setprio(1); _Pragma("unroll") for (int m = 0; m < 4; ++m) _Pragma("unroll") for (int n = 0; n < 2; ++n) { \
        if constexpr (F8) { const i32x8 b8_ = PG8_CAT8(Bt[n]), a8_ = PG8_CAT8(At[m]); asm volatile("v_mfma_f32_16x16x128_f8f6f4 %0, %1, %2, %0" : "+v"(acc[ai][bj][m][n]) : "v"(b8_), "v"(a8_)); } \
        else { _Pragma("unroll") for (int k = 0; k < 2; ++k) acc[ai][bj][m][n] = __builtin_amdgcn_mfma_f32_16x16x32_bf16(Bt[n][k], At[m][k], acc[ai][bj][m][n], 0, 0, 0); } } \
        __builtin_amdgcn_s_setprio(0); } while (0)
#define PG8_WAIT_V(n) asm volatile("s_waitcnt vmcnt(" #n ")" ::: "memory")
#define PG8_WAIT_L(n) asm volatile("s_waitcnt lgkmcnt(" #n ")" ::: "memory")
#define PG8_BAR __builtin_amdgcn_s_barrier()
#define PG8_SCHED __builtin_amdgcn_sched_barrier(0)
    Unit cur, nxt; int ui = 0;
    if (!S.next(0, cur)) return;
    f32x4 acc[2][2][4][2];
#pragma unroll
    for (int a = 0; a < 2; ++a)
#pragma unroll
        for (int b = 0; b < 2; ++b)
#pragma unroll
            for (int m = 0; m < 4; ++m)
#pragma unroll
                for (int n = 0; n < 2; ++n) acc[a][b][m][n] = (f32x4){0.f, 0.f, 0.f, 0.f};
    bf16x8 At[4][2], B0[2][2], B1[2][2];
    const char* cA = (const char*)g.A + (size_t)cur.pm * tstep; const char* cB = (const char*)g.Bt + (size_t)cur.pn * tstep;
    S.a_ready(cur);
    if constexpr (SP2) {
        PG8_STAGE(PG8_SB(0, 0), cB, voffB); PG8_STAGE(PG8_SB(0, 1), cB + hstep, voffB); PG8_STAGE(PG8_SA(0, 0), cA, voffA); PG8_STAGE(PG8_SA(0, 1), cA + hstep, voffA);
        if (wr == 1) PG8_BAR;
        PG8_WAIT_V(2); PG8_BAR;
        PG8_STAGE(PG8_SB(1, 0), cB + kstep, voffB); PG8_STAGE(PG8_SA(1, 0), cA + kstep, voffA); PG8_STAGE(PG8_SB(1, 1), cB + hstep + kstep, voffB);
        PG8_WAIT_V(6); PG8_BAR;
    } else {
        PG8_STAGE(PG8_SB(0, 0), cB, voffB); PG8_STAGE(PG8_SA(0, 0), cA, voffA); PG8_STAGE(PG8_SB(0, 1), cB + hstep, voffB); PG8_STAGE(PG8_SA(0, 1), cA + hstep, voffA);
        if (wr == 1) PG8_BAR;
        PG8_WAIT_V(4); PG8_BAR;
        PG8_STAGE(PG8_SB(1, 0), cB + kstep, voffB); PG8_STAGE(PG8_SA(1, 0), cA + kstep, voffA); PG8_STAGE(PG8_SB(1, 1), cB + hstep + kstep, voffB);
        PG8_WAIT_V(6); PG8_BAR;
    }
    for (;;) {
        const bool has_next = S.next(ui + 1, nxt);
        const char* nA = has_next ? (const char*)g.A + (size_t)nxt.pm * tstep : cA; const char* nB = has_next ? (const char*)g.Bt + (size_t)nxt.pn * tstep : cB;
        for (int t = 0; t < nt; t += 2) {
            const bool last = (t == nt - 2);
            const char* a1 = cA + (size_t)(t + 1) * kstep;
            const char* a2 = last ? nA : cA + (size_t)(t + 2) * kstep; const char* b2 = last ? nB : cB + (size_t)(t + 2) * kstep;
            const char* a3 = a2 + kstep; const char* b3 = b2 + kstep;
            if (last && has_next) S.a_ready(nxt);
            if constexpr (SP2) {
            PG8_LDB(B0, 0, 0); PG8_LDB(B1, 0, 1); PG8_SCHED; PG8_LDA(At, 0, 0); PG8_STAGE(PG8_SA(1, 1), a1 + hstep, voffA);
            PG8_WAIT_V(8); PG8_WAIT_L(0); PG8_BAR; PG8_MMA(0, 0, At, B0); PG8_MMA(0, 1, At, B1); PG8_BAR; PG8_SCHED;
            PG8_LDA(At, 0, 1); PG8_STAGE(PG8_SB(0, 0), b2, voffB); PG8_STAGE(PG8_SB(0, 1), b2 + hstep, voffB); PG8_STAGE(PG8_SA(0, 0), a2, voffA);
            PG8_WAIT_V(8); PG8_WAIT_L(0); PG8_BAR; PG8_MMA(1, 0, At, B0); PG8_MMA(1, 1, At, B1); PG8_BAR; PG8_SCHED;
            PG8_LDB(B0, 1, 0); PG8_LDB(B1, 1, 1); PG8_SCHED; PG8_LDA(At, 1, 0); PG8_STAGE(PG8_SA(0, 1), a2 + hstep, voffA);
            PG8_WAIT_V(8); PG8_WAIT_L(0); PG8_BAR; PG8_MMA(0, 0, At, B0); PG8_MMA(0, 1, At, B1); PG8_BAR; PG8_SCHED;
            PG8_LDA(At, 1, 1); PG8_STAGE(PG8_SB(1, 0), b3, voffB); PG8_STAGE(PG8_SB(1, 1), b3 + hstep, voffB); PG8_STAGE(PG8_SA(1, 0), a3, voffA);
            PG8_WAIT_V(8); PG8_WAIT_L(0); PG8_BAR; PG8_MMA(1, 0, At, B0); PG8_MMA(1, 1, At, B1); PG8_BAR; PG8_SCHED;
            } else {
            PG8_LDB(B0, 0, 0); PG8_SCHED; PG8_LDA(At, 0, 0); PG8_STAGE(PG8_SA(1, 1), a1 + hstep, voffA);
            PG8_WAIT_L(8); PG8_BAR; PG8_WAIT_L(0); PG8_MMA(0, 0, At, B0); PG8_BAR; PG8_SCHED;
            PG8_LDB(B1, 0, 1); PG8_STAGE(PG8_SB(0, 0), b2, voffB);
            PG8_BAR; PG8_WAIT_L(0); PG8_MMA(0, 1, At, B1); PG8_BAR;
            PG8_LDA(At, 0, 1); PG8_STAGE(PG8_SA(0, 0), a2, voffA);
            PG8_BAR; PG8_WAIT_L(0); PG8_MMA(1, 0, At, B0); PG8_BAR; PG8_SCHED;
            PG8_STAGE(PG8_SB(0, 1), b2 + hstep, voffB);
            PG8_WAIT_V(6); PG8_BAR; PG8_MMA(1, 1, At, B1); PG8_BAR;
            PG8_LDB(B0, 1, 0); PG8_SCHED; PG8_LDA(At, 1, 0); PG8_STAGE(PG8_SA(0, 1), a2 + hstep, voffA);
            PG8_WAIT_L(8); PG8_BAR; PG8_WAIT_L(0); PG8_MMA(0, 0, At, B0); PG8_BAR; PG8_SCHED;
            PG8_LDB(B1, 1, 1); PG8_STAGE(PG8_SB(1, 0), b3, voffB);
            PG8_BAR; PG8_WAIT_L(0); PG8_MMA(0, 1, At, B1); PG8_BAR;
            PG8_LDA(At, 1, 1); PG8_STAGE(PG8_SA(1, 0), a3, voffA);
            PG8_BAR; PG8_WAIT_L(0); PG8_MMA(1, 0, At, B0); PG8_BAR; PG8_SCHED;
            PG8_STAGE(PG8_SB(1, 1), b3 + hstep, voffB);
            PG8_WAIT_V(6); PG8_BAR; PG8_MMA(1, 1, At, B1); PG8_BAR;
            }
        }
        if constexpr (ALIGN_EPI) { if (wr == 0) PG8_BAR; }
        if constexpr (F8) {
            asm volatile("s_nop 15\n\ts_nop 15" : "+v"(acc[0][0][0][0]), "+v"(acc[0][0][0][1]), "+v"(acc[0][0][1][0]), "+v"(acc[0][0][1][1]), "+v"(acc[0][0][2][0]), "+v"(acc[0][0][2][1]), "+v"(acc[0][0][3][0]), "+v"(acc[0][0][3][1]),
                         "+v"(acc[0][1][0][0]), "+v"(acc[0][1][0][1]), "+v"(acc[0][1][1][0]), "+v"(acc[0][1][1][1]), "+v"(acc[0][1][2][0]), "+v"(acc[0][1][2][1]), "+v"(acc[0][1][3][0]), "+v"(acc[0][1][3][1]));
            asm volatile("s_nop 15\n\ts_nop 15" : "+v"(acc[1][0][0][0]), "+v"(acc[1][0][0][1]), "+v"(acc[1][0][1][0]), "+v"(acc[1][0][1][1]), "+v"(acc[1][0][2][0]), "+v"(acc[1][0][2][1]), "+v"(acc[1][0][3][0]), "+v"(acc[1][0][3][1]),
                         "+v"(acc[1][1][0][0]), "+v"(acc[1][1][0][1]), "+v"(acc[1][1][1][0]), "+v"(acc[1][1][1][1]), "+v"(acc[1][1][2][0]), "+v"(acc[1][1][2][1]), "+v"(acc[1][1][3][0]), "+v"(acc[1][1][3][1])); }
        if constexpr (!Epi::AFTER_DRAIN) { E(acc, cur, wr, wc, fr, fq); S.done(cur); }
        if (!has_next) break;
#pragma unroll
        for (int a = 0; a < 2; ++a)
#pragma unroll
            for (int b = 0; b < 2; ++b)
#pragma unroll
                for (int m = 0; m < 4; ++m)
#pragma unroll
                    for (int n = 0; n < 2; ++n) acc[a][b][m][n] = (f32x4){0.f, 0.f, 0.f, 0.f};
        cur = nxt; cA = nA; cB = nB; ++ui;
        if constexpr (ALIGN_EPI) { if (wr == 1) PG8_BAR; }
    }
    PG8_WAIT_V(0);
    if constexpr (!ALIGN_EPI) { if (wr == 0) PG8_BAR; }
    PG8_BAR;
    if constexpr (Epi::AFTER_DRAIN) { E.fused(acc, cur, wr, wc, fr, fq, lds, wid, lane); S.done(cur); }
#undef PG8_SA
#undef PG8_SB
#undef PG8_STAGE
#undef PG8_LDA
#undef PG8_LDB
#undef PG8_MMA
#undef PG8_CAT8
#undef PG8_WAIT_V
#undef PG8_WAIT_L
#undef PG8_BAR
#undef PG8_SCHED
}
}
#define GAS __attribute__((address_space(1)))
#define LAS __attribute__((address_space(3)))
typedef unsigned short bf16;
typedef unsigned v4u __attribute__((ext_vector_type(4)));
typedef float f32x4 __attribute__((ext_vector_type(4)));
typedef short bf16x8 __attribute__((ext_vector_type(8)));
typedef GAS unsigned gu32;
typedef GAS unsigned long long gu64;
#define RLX_AGENT __ATOMIC_RELAXED, __HIP_MEMORY_SCOPE_AGENT
#define LDS_WAIT() asm volatile("s_waitcnt lgkmcnt(0)" ::: "memory")
#define VM_WAIT() asm volatile("s_waitcnt vmcnt(0)" ::: "memory")
__device__ __forceinline__ unsigned long long rt() { return __builtin_amdgcn_s_memrealtime(); }
__device__ __forceinline__ unsigned f2bf(float f) { unsigned u = __builtin_bit_cast(unsigned, f); return (u + 0x7fffu + ((u >> 16) & 1u)) >> 16; }
__device__ __forceinline__ unsigned pk2(float lo, float hi) { return f2bf(lo) | (f2bf(hi) << 16); }

#define XB_TMO      128
#define XB_XCNT(j)  (256  + 64 * (j))
#define XB_XSUB(j)  (1280 + 64 * (j))
#define XB_XGEN(j)  (2304 + 64 * (j))
#define XB_TOP      3328
#define XB_TOPGEN   3392
#define XCD_BAR_WORDS 3456
#define XB_SPIN_CAP (1u << 18)

__device__ __forceinline__ unsigned xb_ld(unsigned* p)              { return __hip_atomic_load(p, __ATOMIC_RELAXED, __HIP_MEMORY_SCOPE_AGENT); }
__device__ __forceinline__ unsigned xb_add(unsigned* p, unsigned v) { return __hip_atomic_fetch_add(p, v, __ATOMIC_RELAXED, __HIP_MEMORY_SCOPE_AGENT); }
__device__ __forceinline__ unsigned xb_xcc_id() { return (unsigned)__builtin_amdgcn_s_getreg((3 << 11) | 20) & 0xFu; }
#define XB_SPIN(cond, bar) do { unsigned _sp = 0; while (cond) { __builtin_amdgcn_s_sleep(1); \
    if ((++_sp & 255u) == 0u) { if (xb_ld(&(bar)[XB_TMO])) break; if (_sp > XB_SPIN_CAP) { atomicAdd(&(bar)[XB_TMO], 1u); break; } } } } while (0)

struct XcdBarrier {
    unsigned* bar; unsigned x;
    volatile LAS unsigned* st;
};

__device__ __forceinline__ XcdBarrier xcd_barrier_post(unsigned* bar, volatile LAS unsigned* st) {
    XcdBarrier b; b.bar = bar; b.x = xb_xcc_id(); b.st = st;
    if (threadIdx.x == 0) (void)xb_add(&bar[XB_XCNT(b.x)], 1u);
    return b;
}
__device__ __forceinline__ void xcd_barrier_complete(unsigned* bar, unsigned x, unsigned& nloc, unsigned& nx) {
    const unsigned G = gridDim.x * gridDim.y * gridDim.z;
    unsigned sum, cnt, mine, sp = 0u;
    for (;;) {
        sum = 0u; cnt = 0u; mine = 0u;
#pragma unroll
        for (unsigned j = 0; j < 16; ++j) { const unsigned c = xb_ld(&bar[XB_XCNT(j)]); sum += c; cnt += (c > 0u) ? 1u : 0u; mine = (j == x) ? c : mine; }
        if (sum == G) break;
        __builtin_amdgcn_s_sleep(1);
        if ((++sp & 255u) == 0u) { if (xb_ld(&bar[XB_TMO])) break; if (sp > XB_SPIN_CAP) { atomicAdd(&bar[XB_TMO], 1u); break; } }
    }
    nloc = mine > 0u ? mine : 1u; nx = cnt > 0u ? cnt : 1u;
}

__device__ __forceinline__ void xcd_barrier(const XcdBarrier& b) {
    asm volatile("s_waitcnt vmcnt(0)" ::: "memory");
    __syncthreads();
    if (threadIdx.x == 0) {
        unsigned* bar = b.bar;
        __builtin_amdgcn_s_waitcnt(0);
        unsigned nloc = b.st[0], nx = b.st[1];
        if (nloc == 0u) { xcd_barrier_complete(bar, b.x, nloc, nx); b.st[0] = nloc; b.st[1] = nx; }
        const unsigned old = xb_add(&bar[XB_XSUB(b.x)], 1u);
        const unsigned gen = old / nloc;
        if (old + 1u == (gen + 1u) * nloc) {
            __builtin_amdgcn_fence(__ATOMIC_RELEASE, "agent");
            asm volatile("s_waitcnt vmcnt(0)" ::: "memory");
            const unsigned og = xb_add(&bar[XB_TOP], 1u);
            const unsigned tg = og / nx;
            if (og + 1u == (tg + 1u) * nx) xb_add(&bar[XB_TOPGEN], 1u);
            else XB_SPIN(xb_ld(&bar[XB_TOPGEN]) == tg, bar);
            __builtin_amdgcn_fence(__ATOMIC_ACQUIRE, "agent");
            xb_add(&bar[XB_XGEN(b.x)], 1u);
            asm volatile("s_waitcnt vmcnt(0)" ::: "memory");
        } else {
            XB_SPIN(xb_ld(&bar[XB_XGEN(b.x)]) == gen, bar);
            __builtin_amdgcn_fence(__ATOMIC_ACQUIRE, "agent");
            asm volatile("s_waitcnt vmcnt(0)" ::: "memory");
        }
    }
    __syncthreads();
}

constexpr int NWAVES = 8;
constexpr int DM = 2048, MCTX = 4096, MLAT = 8192, MTOK = MCTX + MLAT, DFF = 5632, INW = 5120, WA = 1024, NADA = 9 * DM;
constexpr float EPS = 1e-6f;
constexpr float LOG2E_F = 1.4426950408889634f;
constexpr int KSPLIT_ADA = 16, ADA_ROWS = DM / KSPLIT_ADA;
#ifndef FFN_FP8
#define FFN_FP8 1
#endif
constexpr int NSET = 5;

constexpr size_t MiB = 1u << 20;
constexpr size_t WS_CTL = 0, CTL_ZERO_BYTES = 1 * MiB;
constexpr size_t WS_MODP = 1 * MiB;
constexpr size_t WS_MOD = 7 * MiB;
constexpr size_t WS_CK = 8 * MiB, WS_CV = 12 * MiB;
constexpr size_t WS_WGU1 = 16 * MiB, WS_WD1 = 60 * MiB, WS_WIN = 82 * MiB, WS_WOUT = 102 * MiB, WS_WGU2 = 110 * MiB, WS_WD2 = 154 * MiB;
constexpr size_t WS_H = 176 * MiB;
constexpr size_t WS_ACT = 224 * MiB;
constexpr size_t WS_Q = 356 * MiB, WS_K = 380 * MiB, WS_V = 404 * MiB, WS_U = 428 * MiB, WS_VG = 452 * MiB;
constexpr size_t WS_MIX = 476 * MiB;
constexpr size_t WS_END = 524 * MiB;
constexpr int CW_BAR = 4096;

constexpr int RING_OFF = 0, RING_BYTES = 131072;
constexpr int LDSCTL_OFF = RING_BYTES, MISC_OFF = LDSCTL_OFF + 320;
constexpr int LDS_BYTES = 147456;

struct Frame {
    LAS unsigned char* lds;
    volatile LAS unsigned* MISC;
    gu32* ctl;
    int tid, lane, wave;
    int vcu, G;
};

__device__ __forceinline__ float wave_sum(float v) {
#pragma unroll
    for (int o = 1; o < 64; o <<= 1) v += __shfl_xor(v, o);
    return v;
}
__device__ __forceinline__ float bf2f(unsigned short b) { return __builtin_bit_cast(float, (unsigned)b << 16); }
__device__ __forceinline__ float bflo(unsigned w) { return __builtin_bit_cast(float, w << 16); }
__device__ __forceinline__ float bfhi(unsigned w) { return __builtin_bit_cast(float, w & 0xffff0000u); }

template <bool F8> __device__ __forceinline__ void p0_transpose_item(const float* W, int K, int N, bf16* WT, int mode, LAS float* scr, int item, int lane) {
    const int nblk = N / 32, kb = item / nblk, nb = item % nblk, k0 = 64 * kb, n0 = 32 * nb;
    const int drow0 = mode == 0 ? n0 : ((n0 >> 7) * 256 + (mode == 2 ? 128 : 0) + (n0 & 127));
#pragma unroll 8
    for (int i = 0; i < 32; ++i) { const int kk = 2 * i + (lane >> 5); scr[kk * 33 + (lane & 31)] = W[(size_t)(k0 + kk) * N + n0 + (lane & 31)]; }
    LDS_WAIT(); asm volatile("" ::: "memory");
    const int c = lane & 7;
#pragma unroll
    for (int j = 0; j < 4; ++j) { const int n = (lane >> 3) + 8 * j; const LAS float* s = scr + (8 * c) * 33 + n;
        if constexpr (F8) { pg8::u32x2 o; o.x = pg8::pack4_fp8(s[0 * 33] * pg8::F8_SW, s[1 * 33] * pg8::F8_SW, s[2 * 33] * pg8::F8_SW, s[3 * 33] * pg8::F8_SW);
            o.y = pg8::pack4_fp8(s[4 * 33] * pg8::F8_SW, s[5 * 33] * pg8::F8_SW, s[6 * 33] * pg8::F8_SW, s[7 * 33] * pg8::F8_SW);
            *(GAS pg8::u32x2*)((unsigned char*)WT + (size_t)(drow0 + n) * K + k0 + 8 * c) = o; }
        else { v4u o; o.x = pk2(s[0 * 33], s[1 * 33]); o.y = pk2(s[2 * 33], s[3 * 33]); o.z = pk2(s[4 * 33], s[5 * 33]); o.w = pk2(s[6 * 33], s[7 * 33]);
            *(GAS v4u*)(WT + (size_t)(drow0 + n) * K + k0 + 8 * c) = o; } }
    LDS_WAIT(); asm volatile("" ::: "memory");
}
__device__ __forceinline__ void p0_ada_item(const float* c_lat, const float* c_ctx, const float* w_ada, float* part, LAS float* scr, int item, int lane) {
    const int cc = item % 72, ks = item / 72, k0 = ks * ADA_ROWS;
    for (int idx = lane; idx < NSET * ADA_ROWS; idx += 64) { const int j = idx / ADA_ROWS, kk = idx % ADA_ROWS;
        const float cv = j == 0 ? c_ctx[k0 + kk] : c_lat[(size_t)(j - 1) * DM + k0 + kk];
        scr[idx] = cv / (1.0f + __expf(-cv)); }
    LDS_WAIT(); asm volatile("" ::: "memory");
    f32x4 acc[NSET];
#pragma unroll
    for (int j = 0; j < NSET; ++j) acc[j] = (f32x4){0.f, 0.f, 0.f, 0.f};
    const float* wp = w_ada + (size_t)k0 * NADA + cc * 256 + lane * 4;
#pragma unroll 2
    for (int k4 = 0; k4 < ADA_ROWS; k4 += 4) {
        f32x4 w[4];
#pragma unroll
        for (int i = 0; i < 4; ++i) w[i] = __builtin_nontemporal_load((const f32x4*)(wp + (size_t)(k4 + i) * NADA));
#pragma unroll
        for (int j = 0; j < NSET; ++j) { const f32x4 s = *(const LAS f32x4*)(scr + j * ADA_ROWS + k4);
            acc[j] += w[0] * s[0]; acc[j] += w[1] * s[1]; acc[j] += w[2] * s[2]; acc[j] += w[3] * s[3]; }
    }
#pragma unroll
    for (int j = 0; j < NSET; ++j) *(f32x4*)(part + ((size_t)(ks * NSET + j)) * NADA + cc * 256 + lane * 4) = acc[j];
    LDS_WAIT(); asm volatile("" ::: "memory");
}

template <bool F8> __device__ __forceinline__ void rownorm_mod_row(const float* xrow, const float* A, const float* B, bf16* orow, int lane) {
    const GAS f32x4* xr = (const GAS f32x4*)xrow + lane;
    f32x4 v[8]; float s = 0.f;
#pragma unroll
    for (int j = 0; j < 8; ++j) { v[j] = xr[64 * j]; s += (v[j].x * v[j].x + v[j].y * v[j].y) + (v[j].z * v[j].z + v[j].w * v[j].w); }
    const float rstd = 1.0f / sqrtf(wave_sum(s) * (1.0f / DM) + EPS);
    GAS unsigned long long* o8 = (GAS unsigned long long*)orow + lane;
#pragma unroll
    for (int j = 0; j < 8; ++j) { const f32x4 a = *((const f32x4*)A + lane + 64 * j), b = *((const f32x4*)B + lane + 64 * j);
        const f32x4 y = v[j] * rstd * a + b;
        if constexpr (F8) ((GAS unsigned*)orow)[lane + 64 * j] = pg8::pack4_fp8(y.x * pg8::F8_SA, y.y * pg8::F8_SA, y.z * pg8::F8_SA, y.w * pg8::F8_SA);
        else o8[64 * j] = (unsigned long long)pg8::cvt_pk_bf16(y.x, y.y) | ((unsigned long long)pg8::cvt_pk_bf16(y.z, y.w) << 32); }
}

typedef float f32x16 __attribute__((ext_vector_type(16)));
typedef short s16x4 __attribute__((ext_vector_type(4)));
__device__ __forceinline__ int crow(int r, int hi) { return (r & 3) + 8 * (r >> 2) + 4 * hi; }
__device__ __forceinline__ s16x4 vtr(const LAS unsigned char* p) { return __builtin_bit_cast(s16x4, __builtin_amdgcn_ds_read_tr16_b64_v4i16((LAS s16x4*)p)); }
constexpr int AT_K = 0, AT_V = 16384, AT_WS = 32768, AT_TB = 32768 + 2048, AT_END = AT_TB + 2048;
struct AttnArgs { const bf16* qb; const bf16* kb; const bf16* vb; const bf16* ckb; const bf16* cvb; bf16* mixb; const float* rpb; };

__device__ __forceinline__ void attn_unit(LAS unsigned char* lds, const AttnArgs& T, bool lat, int b, int h, int rb) {
    const int tid = threadIdx.x, lane = tid & 63, r32 = lane & 31, hi = lane >> 5; const int wid = __builtin_amdgcn_readfirstlane(tid >> 6);
    int nA, nB, gr0 = 0, rq = 0, c0 = 0, rs = 0; const bf16 *KA, *VA; size_t rowA, rowB = 0, qrow;
    if (lat) { rq = 4 * rb + (wid >> 1); c0 = (wid & 1) * 32; rs = min(max(rq - 4, 0), 24);
        const int rs_min = min(max(4 * rb - 4, 0), 24), rs_max = min(max(4 * rb - 1, 0), 24); nB = rs_max + 8 - rs_min; gr0 = rs_min;
        nA = 8; KA = T.ckb; VA = T.cvb; rowA = (size_t)b * 512; rowB = (size_t)MCTX + (size_t)b * 2048 + 64 * rs_min; qrow = (size_t)MCTX + (size_t)b * 2048 + rq * 64 + c0; }
    else { nA = 4; nB = 0; KA = T.kb; VA = T.vb; rowA = (size_t)b * 256; qrow = (size_t)b * 256 + wid * 32; }
    const int NT = nA + nB;
    __syncthreads();
    if (lat && tid < 480) { const int e = tid & 31, dri = tid >> 5; ((LAS float*)(lds + AT_TB))[tid] = e < 31 ? T.rpb[h * 465 + dri * 31 + e] * LOG2E_F : 0.f; }
    bf16x8 qr[4];
#pragma unroll
    for (int d0 = 0; d0 < 4; ++d0) qr[d0] = *(const bf16x8*)(T.qb + (qrow + r32) * WA + h * 64 + d0 * 16 + hi * 8);
    LAS float* wsf = (LAS float*)(lds + AT_WS) + wid * 64;
    f32x16 o[2]; o[0] = (f32x16){}; o[1] = (f32x16){};
    float m_run = -INFINITY, l_run = 0.f;
    v4u kreg, vreg;
#define AT_LOAD(t) do { const bf16* Kp_; const bf16* Vp_; size_t row_; if ((t) < nA) { Kp_ = KA; Vp_ = VA; row_ = rowA + 64 * (size_t)(t); } else { Kp_ = T.kb; Vp_ = T.vb; row_ = rowB + 64 * (size_t)((t) - nA); } \
        kreg = *(const v4u*)(Kp_ + (row_ + lane) * WA + h * 64 + wid * 8); \
        vreg = *(const v4u*)(Vp_ + (row_ + 16 * (wid & 3) + (lane >> 2)) * WA + h * 64 + (wid >> 2) * 32 + (lane & 3) * 8); } while (0)
    AT_LOAD(0);
    for (int t = 0; t < NT; ++t) {
        const int slot = (t & 1) * 8192;
        *(LAS v4u*)(lds + AT_K + slot + wid * 1024 + lane * 16) = kreg;
        *(LAS v4u*)(lds + AT_V + slot + wid * 1024 + lane * 16) = vreg;
        __syncthreads();
        if (t + 1 < NT) AT_LOAD(t + 1);
        const bool local = t >= nA; const int gr = gr0 + (t - nA);
        if (local && (gr < rs || gr >= rs + 8)) continue;
        f32x16 p0, p1;
        if (local) {
            const LAS float* tb = (const LAS float*)(lds + AT_TB) + (gr - rq + 7) * 32;
            const int c = c0 + r32, cs = min(max(c - 8, 0), 48);
#pragma unroll
            for (int r = 0; r < 16; ++r) { const int kc = crow(r, hi), d = kc - c + 15;
                const bool ok0 = kc >= cs && kc < cs + 16, ok1 = kc + 32 >= cs && kc + 32 < cs + 16;
                const float b0 = tb[min(max(d, 0), 31)], b1 = tb[min(max(d + 32, 0), 31)];
                p0[r] = ok0 ? b0 : -1e30f; p1[r] = ok1 ? b1 : -1e30f; }
        } else { p0 = (f32x16){}; p1 = (f32x16){}; }
        const LAS unsigned char* kbp = lds + AT_K + slot + hi * 1024 + r32 * 16;
#pragma unroll
        for (int d0 = 0; d0 < 4; ++d0) { const bf16x8 k0 = *(const LAS bf16x8*)(kbp + d0 * 2048), k1 = *(const LAS bf16x8*)(kbp + d0 * 2048 + 512);
            p0 = __builtin_amdgcn_mfma_f32_32x32x16_bf16(k0, qr[d0], p0, 0, 0, 0); p1 = __builtin_amdgcn_mfma_f32_32x32x16_bf16(k1, qr[d0], p1, 0, 0, 0); }
        float mx = fmaxf(p0[0], p1[0]);
#pragma unroll
        for (int r = 1; r < 16; ++r) mx = fmaxf(mx, fmaxf(p0[r], p1[r]));
        mx = fmaxf(mx, __shfl_xor(mx, 32));
        const float m_new = fmaxf(m_run, mx);
        if (__any(m_new > m_run)) {
            const float alpha = __builtin_amdgcn_exp2f(m_run - m_new);
            l_run *= alpha; m_run = m_new;
            if (hi == 0) wsf[r32] = alpha;
            LDS_WAIT(); asm volatile("" ::: "memory");
#pragma unroll
            for (int g = 0; g < 4; ++g) { const f32x4 af = *(const LAS f32x4*)(wsf + 8 * g + 4 * hi);
#pragma unroll
                for (int i = 0; i < 4; ++i) { o[0][4 * g + i] *= af[i]; o[1][4 * g + i] *= af[i]; } }
        }
        float ls = 0.f;
#pragma unroll
        for (int r = 0; r < 16; ++r) { p0[r] = __builtin_amdgcn_exp2f(p0[r] - m_run); p1[r] = __builtin_amdgcn_exp2f(p1[r] - m_run); ls += p0[r] + p1[r]; }
        l_run += ls;
        v4u pw[4];
#pragma unroll
        for (int s = 0; s < 2; ++s) {
            pw[s] = (v4u){pg8::cvt_pk_bf16(p0[8 * s], p0[8 * s + 1]), pg8::cvt_pk_bf16(p0[8 * s + 2], p0[8 * s + 3]), pg8::cvt_pk_bf16(p0[8 * s + 4], p0[8 * s + 5]), pg8::cvt_pk_bf16(p0[8 * s + 6], p0[8 * s + 7])};
            pw[2 + s] = (v4u){pg8::cvt_pk_bf16(p1[8 * s], p1[8 * s + 1]), pg8::cvt_pk_bf16(p1[8 * s + 2], p1[8 * s + 3]), pg8::cvt_pk_bf16(p1[8 * s + 4], p1[8 * s + 5]), pg8::cvt_pk_bf16(p1[8 * s + 6], p1[8 * s + 7])}; }
        const LAS unsigned char* vbp = lds + AT_V + slot + ((lane >> 4) & 1) * 32 + (lane & 3) * 8 + (4 * hi + ((lane & 15) >> 2)) * 64;
#pragma unroll
        for (int d0 = 0; d0 < 2; ++d0)
#pragma unroll
            for (int ks = 0; ks < 4; ++ks) { const s16x4 lo = vtr(vbp + d0 * 4096 + ks * 1024), hh = vtr(vbp + d0 * 4096 + ks * 1024 + 512);
                const bf16x8 vf = (bf16x8){lo[0], lo[1], lo[2], lo[3], hh[0], hh[1], hh[2], hh[3]};
                o[d0] = __builtin_amdgcn_mfma_f32_32x32x16_bf16(__builtin_bit_cast(bf16x8, pw[ks]), vf, o[d0], 0, 0, 0); }
    }
#undef AT_LOAD
    l_run += __shfl_xor(l_run, 32);
    if (hi == 0) wsf[r32] = 1.0f / l_run;
    LDS_WAIT(); asm volatile("" ::: "memory");
    bf16* Ow = T.mixb + qrow * DM + h * 64 + r32;
#pragma unroll
    for (int g = 0; g < 4; ++g) { const f32x4 af = *(const LAS f32x4*)(wsf + 8 * g + 4 * hi);
#pragma unroll
        for (int i = 0; i < 4; ++i) { const int q = 8 * g + 4 * hi + i;
            Ow[(size_t)q * DM] = (bf16)f2bf(o[0][4 * g + i] * af[i]); Ow[(size_t)q * DM + 32] = (bf16)f2bf(o[1][4 * g + i] * af[i]); } }
}

struct GateArgs { const bf16* ub; const bf16* vgb; const float* w_s; const float* b_s; const float* gnorm; bf16* mixb; };
__device__ __forceinline__ void gate_unit(LAS unsigned char* lds, const GateArgs& T, int n, int g) {
    const int tid = threadIdx.x, lane = tid & 63, r32 = lane & 31, hi = lane >> 5; const int wid = __builtin_amdgcn_readfirstlane(tid >> 6);
    const size_t row0 = (size_t)n * 128;
    __syncthreads();
#pragma unroll
    for (int i = 0; i < 4; ++i) { const int ci = tid + 512 * i, row = ci >> 4, ch = ci & 15;
        const v4u raw = *(const v4u*)(T.vgb + (row0 + row) * WA + g * 128 + ch * 8);
        float v[8]; v[0] = bflo(raw.x); v[1] = bfhi(raw.x); v[2] = bflo(raw.y); v[3] = bfhi(raw.y); v[4] = bflo(raw.z); v[5] = bfhi(raw.z); v[6] = bflo(raw.w); v[7] = bfhi(raw.w);
        float ss = 0.f;
#pragma unroll
        for (int e = 0; e < 8; ++e) ss += v[e] * v[e];
        ss += __shfl_xor(ss, 1); ss += __shfl_xor(ss, 2); ss += __shfl_xor(ss, 4); ss += __shfl_xor(ss, 8);
        const float rstd = 1.0f / sqrtf(ss * (1.0f / 128.0f) + EPS);
        const f32x4 g0 = *(const f32x4*)(T.gnorm + g * 128 + ch * 8), g1 = *(const f32x4*)(T.gnorm + g * 128 + ch * 8 + 4);
        v4u w; w.x = pg8::cvt_pk_bf16(v[0] * rstd * g0[0], v[1] * rstd * g0[1]); w.y = pg8::cvt_pk_bf16(v[2] * rstd * g0[2], v[3] * rstd * g0[3]);
        w.z = pg8::cvt_pk_bf16(v[4] * rstd * g1[0], v[5] * rstd * g1[1]); w.w = pg8::cvt_pk_bf16(v[6] * rstd * g1[2], v[7] * rstd * g1[3]);
        *(LAS v4u*)(lds + (ch >> 2) * 8192 + row * 64 + (ch & 3) * 16) = w; }
    __syncthreads();
    const int ib = wid >> 1, cb0 = 2 * (wid & 1);
    f32x16 acc[2]; acc[0] = (f32x16){}; acc[1] = (f32x16){};
    const float* wrow = T.w_s + ((size_t)g * 128 + 32 * ib + r32) * 128 + 4 * hi;
    const LAS unsigned char* vbp = lds + ((lane >> 4) & 1) * 32 + (lane & 3) * 8 + (4 * hi + ((lane & 15) >> 2)) * 64;
#pragma unroll
    for (int ks = 0; ks < 8; ++ks) {
        const f32x4 a0 = *(const f32x4*)(wrow + 16 * ks), a1 = *(const f32x4*)(wrow + 16 * ks + 8);
        const v4u aw = (v4u){pg8::cvt_pk_bf16(a0[0], a0[1]), pg8::cvt_pk_bf16(a0[2], a0[3]), pg8::cvt_pk_bf16(a1[0], a1[1]), pg8::cvt_pk_bf16(a1[2], a1[3])};
#pragma unroll
        for (int cbi = 0; cbi < 2; ++cbi) { const LAS unsigned char* p = vbp + (cb0 + cbi) * 8192 + ks * 1024;
            const s16x4 lo = vtr(p), hh = vtr(p + 512);
            const bf16x8 vf = (bf16x8){lo[0], lo[1], lo[2], lo[3], hh[0], hh[1], hh[2], hh[3]};
            acc[cbi] = __builtin_amdgcn_mfma_f32_32x32x16_bf16(__builtin_bit_cast(bf16x8, aw), vf, acc[cbi], 0, 0, 0); }
    }
#pragma unroll
    for (int cbi = 0; cbi < 2; ++cbi)
#pragma unroll
        for (int r = 0; r < 16; ++r) { const int i = 32 * ib + crow(r, hi), c = g * 128 + 32 * (cb0 + cbi) + r32;
            const float s = acc[cbi][r] + T.b_s[g * 128 + i];
            const float uu = bf2f(T.ub[(row0 + i) * WA + c]);
            T.mixb[(row0 + i) * DM + WA + c] = (bf16)f2bf(uu * s); }
}

struct Args { const float* in[26]; float* out; unsigned char* ws; int ph_lo, ph_hi, li, pad; };
constexpr int N_PHASES = 14;
__global__ void __launch_bounds__(NWAVES * 64, 2) mega_fwd(Args args) {
    extern __shared__ __attribute__((aligned(16))) unsigned char lds[];
    Frame F;
    F.lds = (LAS unsigned char*)lds;
    F.MISC = (volatile LAS unsigned*)(F.lds + MISC_OFF);
    F.tid = threadIdx.x; F.lane = F.tid & 63; F.wave = __builtin_amdgcn_readfirstlane(F.tid >> 6);
    F.G = gridDim.x; { const int bx = blockIdx.x; F.vcu = (F.G % 8 == 0) ? (bx % 8) * (F.G / 8) + bx / 8 : bx; }
    unsigned char* ws = args.ws;
    F.ctl = (gu32*)(ws + WS_CTL);
    const float* x_prompt = args.in[0]; const float* x_sample = args.in[1];
    float* const xbuf = args.out;
    float* const state_k = args.out + (size_t)MTOK * DM; float* const state_v = state_k + (size_t)MCTX * WA;
    bf16* const Wgu1 = (bf16*)(ws + WS_WGU1); bf16* const Wd1 = (bf16*)(ws + WS_WD1); bf16* const Win = (bf16*)(ws + WS_WIN); bf16* const Wout = (bf16*)(ws + WS_WOUT);
    bf16* const Wgu2 = (bf16*)(ws + WS_WGU2); bf16* const Wd2 = (bf16*)(ws + WS_WD2);
    bf16* const HB = (bf16*)(ws + WS_H); bf16* const ACT = (bf16*)(ws + WS_ACT);
    bf16* const QB = (bf16*)(ws + WS_Q); bf16* const KB = (bf16*)(ws + WS_K); bf16* const VB = (bf16*)(ws + WS_V); bf16* const UB = (bf16*)(ws + WS_U); bf16* const VGB = (bf16*)(ws + WS_VG);
    bf16* const MIXB = (bf16*)(ws + WS_MIX); bf16* const CKB = (bf16*)(ws + WS_CK); bf16* const CVB = (bf16*)(ws + WS_CV);
    float* const MODP = (float*)(ws + WS_MODP); float* const MOD = (float*)(ws + WS_MOD);

    for (int u = F.tid; u < (LDS_BYTES - LDSCTL_OFF) / 4; u += NWAVES * 64) ((LAS unsigned*)(F.lds + LDSCTL_OFF))[u] = 0u;
    __syncthreads();
    XcdBarrier bar = xcd_barrier_post((unsigned*)(F.ctl + CW_BAR) + args.li * XCD_BAR_WORDS, F.MISC + 8);
    const int lo = args.ph_lo, hi = args.ph_hi;
#define IN(k) (lo <= (k) && (k) < hi)
#ifndef PROBE_REPEAT
#define PROBE_REPEAT -1
#endif
#define REP(k) for (int rep_ = 0; rep_ < ((PROBE_REPEAT == (k)) ? 2 : 1); ++rep_)
#define REPBAR() do { if (rep_) xcd_barrier(bar); } while (0)
#define SEAM(k) do { if (IN(k) && IN((k) + 1)) xcd_barrier(bar); } while (0)
    const int gw = F.vcu * NWAVES + F.wave, NGW = F.G * NWAVES;

    if (IN(0)) REP(0) { REPBAR();
        LAS float* scr = (LAS float*)(F.lds + RING_OFF + F.wave * 16384);
        { const int gt = F.vcu * (NWAVES * 64) + F.tid, NGT = F.G * NWAVES * 64;
          for (int i = gt; i < 2 * 262144; i += NGT) { const int which = i >= 262144, e = (which ? i - 262144 : i) * 8; const float* src = args.in[2 + which] + e;
              const f32x4 a = *(const f32x4*)src, b2 = *(const f32x4*)(src + 4);
              v4u o; o.x = pg8::cvt_pk_bf16(a[0], a[1]); o.y = pg8::cvt_pk_bf16(a[2], a[3]); o.z = pg8::cvt_pk_bf16(b2[0], b2[1]); o.w = pg8::cvt_pk_bf16(b2[2], b2[3]);
              *(v4u*)((which ? CVB : CKB) + e) = o; } }
        constexpr int I_GU = 32 * 176, I_D = 88 * 64, I_IN = 32 * 160, I_OUT = 32 * 64;
        constexpr int NTR = 6 * I_GU + I_IN + I_OUT;
        static_assert(I_GU == I_D && NTR == 40960, "item count");
        int t0, t1;
        if (NGW == 2048) { if (gw < 1152) { p0_ada_item(args.in[4], args.in[5], args.in[6], MODP, scr, gw, F.lane); t0 = gw * 13; t1 = t0 + 13; } else { t0 = 14976 + (gw - 1152) * 29; t1 = t0 + 29; } }
        else { for (int it = gw; it < 1152; it += NGW) p0_ada_item(args.in[4], args.in[5], args.in[6], MODP, scr, it, F.lane); const int per = (NTR + NGW - 1) / NGW; t0 = gw * per; t1 = min(t0 + per, NTR); }
        for (int it = t0; it < t1; ++it) {
            int r = it;
            if (r < I_GU) { p0_transpose_item<FFN_FP8>(args.in[9], DM, DFF, Wgu1, 1, scr, r, F.lane); continue; } r -= I_GU;
            if (r < I_GU) { p0_transpose_item<FFN_FP8>(args.in[10], DM, DFF, Wgu1, 2, scr, r, F.lane); continue; } r -= I_GU;
            if (r < I_D) { p0_transpose_item<FFN_FP8>(args.in[11], DFF, DM, Wd1, 0, scr, r, F.lane); continue; } r -= I_D;
            if (r < I_IN) { p0_transpose_item<false>(args.in[13], DM, INW, Win, 0, scr, r, F.lane); continue; } r -= I_IN;
            if (r < I_OUT) { p0_transpose_item<false>(args.in[20], DM, DM, Wout, 0, scr, r, F.lane); continue; } r -= I_OUT;
            if (r < I_GU) { p0_transpose_item<FFN_FP8>(args.in[22], DM, DFF, Wgu2, 1, scr, r, F.lane); continue; } r -= I_GU;
            if (r < I_GU) { p0_transpose_item<FFN_FP8>(args.in[23], DM, DFF, Wgu2, 2, scr, r, F.lane); continue; } r -= I_GU;
            p0_transpose_item<FFN_FP8>(args.in[24], DFF, DM, Wd2, 0, scr, r, F.lane);
        }
    }
    SEAM(0);
    if (IN(1)) REP(1) { REPBAR();
        const int gt = F.vcu * (NWAVES * 64) + F.tid, NGT = F.G * NWAVES * 64;
        for (int idx = gt; idx < NSET * NADA; idx += NGT) { const int j = idx / NADA, n = idx % NADA, chunk = n >> 11, col = n & 2047;
            float s = args.in[7][n];
#pragma unroll
            for (int ks = 0; ks < KSPLIT_ADA; ++ks) s += MODP[((size_t)(ks * NSET + j)) * NADA + n];
            const int sub = chunk / 3, kind = chunk % 3;
            if (kind == 1) { const float* gn = sub == 0 ? args.in[8] : sub == 1 ? args.in[12] : args.in[21]; s = gn[col] * (1.0f + s); }
            else if (kind == 2 && sub != 1) s *= 0.5f;
            MOD[(size_t)j * NADA + n] = s; }
    }
    SEAM(1);
    if (IN(2)) REP(2) { REPBAR();
        for (int m = gw; m < MTOK; m += NGW) { const int j = m < MCTX ? 0 : 1 + ((m - MCTX) >> 11);
            const float* xr = m < MCTX ? x_prompt + (size_t)m * DM : x_sample + (size_t)(m - MCTX) * DM;
            rownorm_mod_row<FFN_FP8>(xr, MOD + (size_t)j * NADA + 1 * DM, MOD + (size_t)j * NADA + 0 * DM, HB + (size_t)m * (FFN_FP8 ? DM / 2 : DM), F.lane); }
    }
    SEAM(2);
    if (IN(3)) REP(3) { REPBAR();
        pg8::Gemm g{HB, Wgu1, MTOK, 2 * DFF, FFN_FP8 ? DM / 2 : DM}; pg8::StaticOrder S; S.init(MTOK, 2 * DFF, F.G, (int)blockIdx.x);
#if FFN_FP8
        pg8::EpiSwiGLU8 E{(unsigned char*)ACT, DFF};
        pg8::gemm_phase<pg8::EpiSwiGLU8, pg8::StaticOrder, true, true, true>(F.lds + RING_OFF, g, S, E);
#else
        pg8::EpiSwiGLU E{ACT, DFF, 0};
#if PROBE_REPEAT == 3 && defined(PROBE_NULL_EPI)
        E.skip = rep_;
#endif
        pg8::gemm_phase<pg8::EpiSwiGLU, pg8::StaticOrder, true, true>(F.lds + RING_OFF, g, S, E);
#endif
    }
    SEAM(3);
    if (IN(4)) REP(4) { REPBAR();
        pg8::Gemm g{ACT, Wd1, MTOK, DM, FFN_FP8 ? DFF / 2 : DFF}; pg8::StaticOrder S; S.init(MTOK, DM, F.G, (int)blockIdx.x);
        pg8::EpiRes E{x_prompt, x_sample, xbuf, MOD + 2 * DM, DM, FFN_FP8 ? pg8::F8_DQ : 1.0f};
        pg8::gemm_phase<pg8::EpiRes, pg8::StaticOrder, true, true, FFN_FP8>(F.lds + RING_OFF, g, S, E);
    }
    SEAM(4);
    if (IN(5)) REP(5) { REPBAR();
        for (int m = gw; m < MTOK; m += NGW) { const int j = m < MCTX ? 0 : 1 + ((m - MCTX) >> 11);
            rownorm_mod_row<false>(xbuf + (size_t)m * DM, MOD + (size_t)j * NADA + 4 * DM, MOD + (size_t)j * NADA + 3 * DM, HB + (size_t)m * DM, F.lane); }
    }
    SEAM(5);
    if (IN(6)) REP(6) { REPBAR();
        pg8::Gemm g{HB, Win, MTOK, INW, DM}; pg8::StaticOrder S; S.init(MTOK, INW, F.G, (int)blockIdx.x);
        pg8::EpiMixIn E{QB, KB, VB, UB, VGB, state_k, state_v, 0.125f * LOG2E_F};
        pg8::gemm_phase<pg8::EpiMixIn, pg8::StaticOrder, true, true>(F.lds + RING_OFF, g, S, E);
    }
    SEAM(6);
    if (IN(7)) REP(7) { REPBAR();
        const AttnArgs AT{QB, KB, VB, CKB, CVB, MIXB, args.in[14]};
        const GateArgs GT{UB, VGB, args.in[16], args.in[17], args.in[15], MIXB};
        REP(70) { REPBAR(); for (int u = F.vcu; u < 512; u += F.G) attn_unit(F.lds + RING_OFF, AT, true, u >> 7, (u >> 3) & 15, u & 7); }
        REP(71) { REPBAR(); for (int u = F.vcu; u < 256; u += F.G) attn_unit(F.lds + RING_OFF, AT, false, u >> 4, u & 15, 0); }
        REP(72) { REPBAR(); for (int u = F.vcu; u < 768; u += F.G) gate_unit(F.lds + RING_OFF, GT, u >> 3, u & 7); }
    }
    SEAM(7);
    if (IN(8)) REP(8) { REPBAR();
        for (int m = gw; m < MTOK; m += NGW) {
            v4u* rowp = (v4u*)(MIXB + (size_t)m * DM) + F.lane;
#pragma unroll
            for (int half = 0; half < 2; ++half) {
                v4u raw[2]; float v[16]; float ss = 0.f;
#pragma unroll
                for (int j = 0; j < 2; ++j) { raw[j] = rowp[half * 128 + 64 * j];
                    v[8 * j + 0] = bflo(raw[j].x); v[8 * j + 1] = bfhi(raw[j].x); v[8 * j + 2] = bflo(raw[j].y); v[8 * j + 3] = bfhi(raw[j].y);
                    v[8 * j + 4] = bflo(raw[j].z); v[8 * j + 5] = bfhi(raw[j].z); v[8 * j + 6] = bflo(raw[j].w); v[8 * j + 7] = bfhi(raw[j].w); }
#pragma unroll
                for (int e = 0; e < 16; ++e) ss += v[e] * v[e];
                const float rstd = 1.0f / sqrtf(wave_sum(ss) * (1.0f / WA) + EPS);
                const float* gn = args.in[18 + half];
#pragma unroll
                for (int j = 0; j < 2; ++j) { const f32x4 g0 = *(const f32x4*)(gn + (F.lane + 64 * j) * 8), g1 = *(const f32x4*)(gn + (F.lane + 64 * j) * 8 + 4);
                    v4u w; w.x = pg8::cvt_pk_bf16(v[8 * j + 0] * rstd * g0[0], v[8 * j + 1] * rstd * g0[1]); w.y = pg8::cvt_pk_bf16(v[8 * j + 2] * rstd * g0[2], v[8 * j + 3] * rstd * g0[3]);
                    w.z = pg8::cvt_pk_bf16(v[8 * j + 4] * rstd * g1[0], v[8 * j + 5] * rstd * g1[1]); w.w = pg8::cvt_pk_bf16(v[8 * j + 6] * rstd * g1[2], v[8 * j + 7] * rstd * g1[3]);
                    rowp[half * 128 + 64 * j] = w; }
            }
        }
    }
    SEAM(8);
    if (IN(9)) REP(9) { REPBAR();
        pg8::Gemm g{MIXB, Wout, MTOK, DM, DM}; pg8::StaticOrder S; S.init(MTOK, DM, F.G, (int)blockIdx.x);
        pg8::EpiRes E{xbuf, xbuf + (size_t)MCTX * DM, xbuf, MOD + 5 * DM, DM, 1.0f};
        pg8::gemm_phase<pg8::EpiRes, pg8::StaticOrder, true, true>(F.lds + RING_OFF, g, S, E);
    }
    SEAM(9);
    if (IN(10)) REP(10) { REPBAR();
        for (int m = gw; m < MTOK; m += NGW) { const int j = m < MCTX ? 0 : 1 + ((m - MCTX) >> 11);
            rownorm_mod_row<FFN_FP8>(xbuf + (size_t)m * DM, MOD + (size_t)j * NADA + 7 * DM, MOD + (size_t)j * NADA + 6 * DM, HB + (size_t)m * (FFN_FP8 ? DM / 2 : DM), F.lane); }
    }
    SEAM(10);
    if (IN(11)) REP(11) { REPBAR();
        pg8::Gemm g{HB, Wgu2, MTOK, 2 * DFF, FFN_FP8 ? DM / 2 : DM}; pg8::StaticOrder S; S.init(MTOK, 2 * DFF, F.G, (int)blockIdx.x);
#if FFN_FP8
        pg8::EpiSwiGLU8 E{(unsigned char*)ACT, DFF};
        pg8::gemm_phase<pg8::EpiSwiGLU8, pg8::StaticOrder, true, true, true>(F.lds + RING_OFF, g, S, E);
#else
        pg8::EpiSwiGLU E{ACT, DFF, 0};
        pg8::gemm_phase<pg8::EpiSwiGLU, pg8::StaticOrder, true, true>(F.lds + RING_OFF, g, S, E);
#endif
    }
    SEAM(11);
    if (IN(12)) REP(12) { REPBAR();
        pg8::Gemm g{ACT, Wd2, MTOK, DM, FFN_FP8 ? DFF / 2 : DFF}; pg8::StaticOrder S; S.init(MTOK, DM, F.G, (int)blockIdx.x);
        pg8::EpiRes E{xbuf, xbuf + (size_t)MCTX * DM, xbuf, MOD + 8 * DM, DM, FFN_FP8 ? pg8::F8_DQ : 1.0f};
        pg8::gemm_phase<pg8::EpiRes, pg8::StaticOrder, true, true, FFN_FP8>(F.lds + RING_OFF, g, S, E);
    }
    SEAM(12);
    if (IN(13)) REP(13) { REPBAR();
        const float* fg = args.in[25];
        for (int m = gw; m < MTOK; m += NGW) {
            GAS f32x4* xr = (GAS f32x4*)(xbuf + (size_t)m * DM) + F.lane;
            f32x4 v[8]; float s = 0.f;
#pragma unroll
            for (int j = 0; j < 8; ++j) { v[j] = xr[64 * j]; s += (v[j].x * v[j].x + v[j].y * v[j].y) + (v[j].z * v[j].z + v[j].w * v[j].w); }
            const float rstd = 1.0f / sqrtf(wave_sum(s) * (1.0f / DM) + EPS);
#pragma unroll
            for (int j = 0; j < 8; ++j) xr[64 * j] = v[j] * rstd * *((const f32x4*)fg + F.lane + 64 * j);
        }
    }
#undef IN
#undef SEAM
}

#ifndef MK_N_LAUNCHES
#define MK_N_LAUNCHES 1
#endif
extern "C" void kernel_launch(void* const* d_in, const int* in_sizes, int n_in, void* d_out, int out_size, void* d_ws, size_t ws_size, hipStream_t stream) {
    static int grid = 0;
    if (grid == 0) {
        if (n_in != 26 || out_size != MTOK * DM + 2 * MCTX * WA || ws_size < WS_END) { fprintf(stderr, "kernel_launch: unexpected shapes: n_in %d out %d ws %zu (need %zu); nothing launched\n", n_in, out_size, ws_size, (size_t)WS_END); grid = -1; return; }
        int dev = 0, cus = 0, per_cu = 0;
        if (hipGetDevice(&dev) != hipSuccess || hipDeviceGetAttribute(&cus, hipDeviceAttributeMultiprocessorCount, dev) != hipSuccess) { fprintf(stderr, "kernel_launch: device query failed\n"); grid = -1; return; }
        if (hipFuncSetAttribute((const void*)mega_fwd, hipFuncAttributeMaxDynamicSharedMemorySize, LDS_BYTES) != hipSuccess) { fprintf(stderr, "kernel_launch: hipFuncSetAttribute failed\n"); grid = -1; return; }
        if (hipOccupancyMaxActiveBlocksPerMultiprocessor(&per_cu, (const void*)mega_fwd, NWAVES * 64, LDS_BYTES) != hipSuccess || per_cu < 1)
            fprintf(stderr, "kernel_launch: note: occupancy query reports %d workgroups per CU\n", per_cu);
        (void)hipGetLastError();
        grid = cus;
    }
    if (grid < 0) return;
    if (hipMemsetAsync((char*)d_ws + WS_CTL, 0, CTL_ZERO_BYTES, stream) != hipSuccess) { fprintf(stderr, "kernel_launch: hipMemsetAsync failed\n"); return; }
    Args a{};
    for (int i = 0; i < 26; ++i) a.in[i] = (const float*)d_in[i];
    a.out = (float*)d_out; a.ws = (unsigned char*)d_ws;
    if (MK_N_LAUNCHES == 1) { a.ph_lo = 0; a.ph_hi = N_PHASES; a.li = 0; hipLaunchKernelGGL(mega_fwd, dim3(grid), dim3(NWAVES * 64), LDS_BYTES, stream, a); }
    else { for (int p = 0; p < N_PHASES; ++p) { a.ph_lo = p; a.ph_hi = p + 1; a.li = 0; hipLaunchKernelGGL(mega_fwd, dim3(grid), dim3(NWAVES * 64), LDS_BYTES, stream, a); } }
    const hipError_t le = hipPeekAtLastError();
    if (le != hipSuccess) fprintf(stderr, "kernel_launch: launch failed: %s\n", hipGetErrorName(le));
}
```

```cpp
#include <hip/hip_runtime.h>
#include <cstdio>
#include <cstdint>
namespace pg8 {
#define PG8_LAS __attribute__((address_space(3)))
typedef unsigned short bf16_t;
typedef short bf16x8 __attribute__((ext_vector_type(8)));
typedef float f32x4 __attribute__((ext_vector_type(4)));
typedef unsigned u32x4 __attribute__((ext_vector_type(4)));
typedef int i32x4 __attribute__((ext_vector_type(4)));
typedef int i32x8 __attribute__((ext_vector_type(8)));
constexpr int BM = 256, BK = 64, HALF = 128, HTB = HALF * BK * 2  , STAGE_BYTES = 8 * HTB, NXCD = 8, WGM = 8;

__host__ __device__ __forceinline__ int lds_byte(int r, int c) { const int st = (r >> 4) * 2 + (c >> 5), rr = r & 15, cc = c & 31, ob = rr * 64 + cc * 2; return st * 1024 + (ob ^ (((ob >> 9) & 1) << 5)); }
__host__ __device__ __forceinline__ void stage_rc(int b, int& R, int& C) { const int st = b / 1024, sb = b % 1024, swz = sb ^ (((sb >> 9) & 1) << 5); R = (st >> 1) * 16 + swz / 64; C = (st & 1) * 32 + (swz % 64) / 2; }
__host__ __device__ __forceinline__ int perm32(int rho) { const int n = rho >> 4, i = rho & 15; return 8 * (i >> 2) + 4 * n + (i & 3); }

struct Unit { int pm, pn, k0, nt, part; };
struct Gemm { const bf16_t* A; const bf16_t* Bt; int M, N, K; };

struct StaticOrder {
    int nM, nN, nwg, G, c;
    __host__ __device__ void init(int M, int N, int G_, int c_) { nM = M / BM; nN = N / BM; nwg = nM * nN; G = G_; c = c_; }
    __host__ __device__ bool next(int i, Unit& u) const {
        const long L = (long)i * G + c; if (L >= nwg) return false;
        int wgid = (int)L; { const int q = nwg / NXCD, r = nwg % NXCD, xcd = wgid % NXCD, off = wgid / NXCD; wgid = (xcd < r ? xcd * (q + 1) : r * (q + 1) + (xcd - r) * q) + off; }
        const int nig = WGM * nN, gid = wgid / nig, fm = gid * WGM, gsz = (nM - fm) < WGM ? (nM - fm) : WGM;
        u.pm = fm + ((wgid % nig) % gsz); u.pn = (wgid % nig) / gsz; u.k0 = 0; u.nt = 0; u.part = 0; return true;
    }
    __device__ __forceinline__ void a_ready(const Unit&) const {}
    __device__ __forceinline__ void done(const Unit&) const {}
};
struct SplitOrder {
    int v, nth;
    __device__ __forceinline__ bool next(int i, Unit& u) const {
        if (i == 0) { u.pm = v >> 3; u.pn = v & 7; u.k0 = 0; u.nt = 0; u.part = 0; return true; }
        if (i == 1) { const int s = v >> 1, half = v & 1; u.pm = 32 + (s >> 3); u.pn = s & 7; u.k0 = half * nth; u.nt = nth; u.part = half; return true; }
        return false;
    }
    __device__ __forceinline__ void a_ready(const Unit&) const {}
    __device__ __forceinline__ void done(const Unit&) const {}
};
struct FlexOrder {
    StaticOrder st; SplitOrder sp; bool split;
    __device__ __forceinline__ bool next(int i, Unit& u) const { return split ? sp.next(i, u) : st.next(i, u); }
    __device__ __forceinline__ void a_ready(const Unit&) const {}
    __device__ __forceinline__ void done(const Unit&) const {}
};


__device__ __forceinline__ unsigned cvt_pk_bf16(float lo, float hi) { unsigned r; asm volatile("v_cvt_pk_bf16_f32 %0, %1, %2" : "=v"(r) : "v"(lo), "v"(hi)); return r; }
typedef float f32x2 __attribute__((ext_vector_type(2)));
typedef unsigned u32x2 __attribute__((ext_vector_type(2)));
constexpr float LOG2E = 1.4426950408889634f;
__device__ __forceinline__ float silu_f(float g) { return g * __builtin_amdgcn_rcpf(1.0f + __builtin_amdgcn_exp2f(-LOG2E * g)); }
__device__ __forceinline__ float gelu_tanh_f(float x) { const float t = x * (-2.3022081983f + -0.1029432407f * x * x); return x * __builtin_amdgcn_rcpf(1.0f + __builtin_amdgcn_exp2f(t)); }

__device__ __forceinline__ int mod_set_of_tile(int pm) { return pm < 16 ? 0 : 1 + ((pm - 16) >> 3); }
constexpr int MOD_JSTRIDE = 9 * 2048;

__device__ __forceinline__ unsigned pack4_fp8(float a, float b, float c, float d) {
    a = __builtin_fminf(__builtin_fmaxf(a, -448.f), 448.f); b = __builtin_fminf(__builtin_fmaxf(b, -448.f), 448.f);
    c = __builtin_fminf(__builtin_fmaxf(c, -448.f), 448.f); d = __builtin_fminf(__builtin_fmaxf(d, -448.f), 448.f);
    int p = __builtin_amdgcn_cvt_pk_fp8_f32(a, b, 0, false); p = __builtin_amdgcn_cvt_pk_fp8_f32(c, d, p, true); return (unsigned)p;
}
constexpr float F8_SA = 8.0f, F8_SW = 128.0f, F8_DQ = 1.0f / (F8_SA * F8_SW);
struct EpiSwiGLU8 {
    static constexpr bool PERM = true, AFTER_DRAIN = false;
    unsigned char* O; int ldc;
    __device__ __forceinline__ void operator()(const f32x4 (&acc)[2][2][4][2], const Unit& u, int wr, int wc, int fr, int fq) const {
        const int row0 = u.pm * BM + wr * 64 + fr, col0 = u.pn * HALF + wc * 32 + 8 * fq;
#pragma unroll
        for (int ai = 0; ai < 2; ++ai)
#pragma unroll
            for (int m = 0; m < 4; ++m) { unsigned char* rowp = O + (size_t)(row0 + ai * HALF + m * 16) * ldc + col0;
                const f32x4 g0 = acc[ai][0][m][0] * F8_DQ, g1 = acc[ai][0][m][1] * F8_DQ, u0 = acc[ai][1][m][0] * (F8_DQ * F8_SA), u1 = acc[ai][1][m][1] * (F8_DQ * F8_SA);
                u32x2 w; w.x = pack4_fp8(silu_f(g0[0]) * u0[0], silu_f(g0[1]) * u0[1], silu_f(g0[2]) * u0[2], silu_f(g0[3]) * u0[3]);
                w.y = pack4_fp8(silu_f(g1[0]) * u1[0], silu_f(g1[1]) * u1[1], silu_f(g1[2]) * u1[2], silu_f(g1[3]) * u1[3]);
                *(u32x2*)rowp = w; }
    }
};

struct EpiSwiGLU {
    static constexpr bool PERM = true, AFTER_DRAIN = false;
    bf16_t* O; int ldc; int skip;
    __device__ __forceinline__ void operator()(const f32x4 (&acc)[2][2][4][2], const Unit& u, int wr, int wc, int fr, int fq) const {
#if defined(PROBE_NULL_EPI)
        if (skip) {
#pragma unroll
            for (int ai = 0; ai < 2; ++ai)
#pragma unroll
                for (int bj = 0; bj < 2; ++bj)
#pragma unroll
                    for (int m = 0; m < 4; ++m)
#pragma unroll
                        for (int n = 0; n < 2; ++n) asm volatile("" :: "v"(acc[ai][bj][m][n]));
            return; }
#endif
        const int row0 = u.pm * BM + wr * 64 + fr, col0 = u.pn * HALF + wc * 32 + 8 * fq;
#pragma unroll
        for (int ai = 0; ai < 2; ++ai)
#pragma unroll
            for (int m = 0; m < 4; ++m) { bf16_t* rowp = O + (size_t)(row0 + ai * HALF + m * 16) * ldc + col0;
                const f32x4 g0 = acc[ai][0][m][0], g1 = acc[ai][0][m][1], u0 = acc[ai][1][m][0], u1 = acc[ai][1][m][1];
                u32x4 w; w.x = cvt_pk_bf16(silu_f(g0[0]) * u0[0], silu_f(g0[1]) * u0[1]); w.y = cvt_pk_bf16(silu_f(g0[2]) * u0[2], silu_f(g0[3]) * u0[3]);
                w.z = cvt_pk_bf16(silu_f(g1[0]) * u1[0], silu_f(g1[1]) * u1[1]); w.w = cvt_pk_bf16(silu_f(g1[2]) * u1[2], silu_f(g1[3]) * u1[3]);
                *(u32x4*)rowp = w; }
    }
};

struct EpiRes {
    static constexpr bool PERM = false, AFTER_DRAIN = false;
    const float* base_ctx; const float* base_lat; float* out; const float* gtab; int ldc; float dq; float* pbuf;
    __device__ __forceinline__ void operator()(const f32x4 (&acc)[2][2][4][2], const Unit& u, int wr, int wc, int fr, int fq) const {
        const int row0 = u.pm * BM + wr * 64 + fr, col0 = u.pn * BM + wc * 32 + 4 * fq;
        const float* gv = gtab + (size_t)mod_set_of_tile(u.pm) * MOD_JSTRIDE;
        const float* bbase = u.pm < 16 ? base_ctx : base_lat; const int brow0 = u.pm < 16 ? row0 : row0 - 4096;
        f32x4 gvv[2][2];
#pragma unroll
        for (int bj = 0; bj < 2; ++bj)
#pragma unroll
            for (int n = 0; n < 2; ++n) gvv[bj][n] = *(const f32x4*)(gv + col0 + bj * HALF + n * 16) * dq;
#pragma unroll
        for (int ai = 0; ai < 2; ++ai)
#pragma unroll
            for (int m = 0; m < 4; ++m) { const size_t boff = (size_t)(brow0 + ai * HALF + m * 16) * ldc + col0, ooff = (size_t)(row0 + ai * HALF + m * 16) * ldc + col0;
#pragma unroll
                for (int bj = 0; bj < 2; ++bj)
#pragma unroll
                    for (int n = 0; n < 2; ++n) {
                        if (u.part) *(f32x4*)(pbuf + ooff - (size_t)8192 * ldc + bj * HALF + n * 16) = gvv[bj][n] * acc[ai][bj][m][n];
                        else { const f32x4 bs = *(const f32x4*)(bbase + boff + bj * HALF + n * 16);
                            *(f32x4*)(out + ooff + bj * HALF + n * 16) = bs + gvv[bj][n] * acc[ai][bj][m][n]; } } }
    }
};

struct EpiMixIn {
    static constexpr bool PERM = true, AFTER_DRAIN = false;
    bf16_t* qb; bf16_t* kb; bf16_t* vb; bf16_t* ub; bf16_t* vgb; float* state_k; float* state_v; float qscale;
    __device__ __forceinline__ void operator()(const f32x4 (&acc)[2][2][4][2], const Unit& u, int wr, int wc, int fr, int fq) const {
        const int row0 = u.pm * BM + wr * 64 + fr;
#pragma unroll
        for (int bj = 0; bj < 2; ++bj) {
            const int colg = u.pn * BM + bj * HALF, region = colg >> 10, cb = (colg & 1023) + wc * 32 + 8 * fq;
            bf16_t* dst = region == 0 ? qb : region == 1 ? kb : region == 2 ? vb : region == 3 ? ub : vgb;
            float* st = region == 1 ? state_k : state_v; const bool wst = (region == 1 || region == 2) && u.pm < 16;
#pragma unroll
            for (int ai = 0; ai < 2; ++ai)
#pragma unroll
                for (int m = 0; m < 4; ++m) { const int row = row0 + ai * HALF + m * 16; f32x4 v0 = acc[ai][bj][m][0], v1 = acc[ai][bj][m][1];
                    if (wst) { *(f32x4*)(st + (size_t)row * 1024 + cb) = v0; *(f32x4*)(st + (size_t)row * 1024 + cb + 4) = v1; }
                    if (region == 0) { v0 = v0 * qscale; v1 = v1 * qscale; }
                    if (region >= 3) {
#pragma unroll
                        for (int i = 0; i < 4; ++i) { v0[i] = gelu_tanh_f(v0[i]); v1[i] = gelu_tanh_f(v1[i]); } }
                    u32x4 w; w.x = cvt_pk_bf16(v0[0], v0[1]); w.y = cvt_pk_bf16(v0[2], v0[3]); w.z = cvt_pk_bf16(v1[0], v1[1]); w.w = cvt_pk_bf16(v1[2], v1[3]);
                    *(u32x4*)(dst + (size_t)row * 1024 + cb) = w; }
        }
    }
};

struct EpiNull {
    static constexpr bool PERM = true, AFTER_DRAIN = false;
    __device__ __forceinline__ void operator()(const f32x4 (&acc)[2][2][4][2], const Unit& u, int wr, int wc, int fr, int fq) const {
#pragma unroll
        for (int ai = 0; ai < 2; ++ai)
#pragma unroll
            for (int bj = 0; bj < 2; ++bj)
#pragma unroll
                for (int m = 0; m < 4; ++m)
#pragma unroll
                    for (int n = 0; n < 2; ++n) asm volatile("" :: "v"(acc[ai][bj][m][n]));
    }
};

template <class Epi, class Sched, bool ALIGN_EPI = false, bool SP2 = false, bool F8 = false>
__device__ __forceinline__ void gemm_phase(PG8_LAS unsigned char* lds, const Gemm g, const Sched& S, const Epi& E) {
    const int tid = threadIdx.x, wid = __builtin_amdgcn_readfirstlane(tid >> 6), lane = tid & 63, wr = wid >> 2, wc = wid & 3, fr = lane & 15, fq = lane >> 4;
    const int K = g.K, nt_full = K / BK; int nt = nt_full;
    unsigned voffA[2], voffB[2];
#pragma unroll
    for (int i = 0; i < 2; ++i) { int R, C; stage_rc(tid * 16 + i * 8192, R, C); const int Rb = Epi::PERM ? ((R & ~31) + perm32(R & 31)) : R;
        voffA[i] = (unsigned)(R * K + C) * 2u; voffB[i] = (unsigned)(Rb * K + C) * 2u; }
    const size_t kstep = (size_t)(BK * 2);
    const size_t hstep = (size_t)HALF * K * 2;
    const size_t tstep = 2 * hstep;
    const unsigned ldsw = (unsigned)wid * 1024u;
    const int aoff = lds_byte(wr * 64 + fr, fq * 8), boff = lds_byte(wc * 32 + fr, fq * 8);
    const int a8 = lds_byte(wr * 64 + fr, fq * 16), b8 = lds_byte(wc * 32 + fr, fq * 16);
    const int aoffk0 = F8 ? a8 + (fq & 1) * 16 : aoff, aoffk1 = F8 ? a8 + ((fq & 1) ^ 1) * 16 : aoff + 1024;
    const int boffk0 = F8 ? b8 + (fq & 1) * 16 : boff, boffk1 = F8 ? b8 + ((fq & 1) ^ 1) * 16 : boff + 1024;
#define PG8_SA(b, h) (((b) * 2 + (h)) * HTB)
#define PG8_SB(b, h) ((4 + (b) * 2 + (h)) * HTB)
#define PG8_STAGE(bufoff, gbase, voff) do { _Pragma("unroll") for (int _i = 0; _i < 2; ++_i) \
        __builtin_amdgcn_global_load_lds((const unsigned*)((const char*)(gbase) + (voff)[_i]), (PG8_LAS unsigned*)(lds + (bufoff) + ldsw + _i * 8192), 16, 0, 0); } while (0)
#define PG8_LDA(dst, b, h) do { _Pragma("unroll") for (int m = 0; m < 4; ++m) { dst[m][0] = *(const PG8_LAS bf16x8*)(lds + PG8_SA(b, h) + aoffk0 + m * 2048); dst[m][1] = *(const PG8_LAS bf16x8*)(lds + PG8_SA(b, h) + aoffk1 + m * 2048); } } while (0)
#define PG8_LDB(dst, b, h) do { _Pragma("unroll") for (int n = 0; n < 2; ++n) { dst[n][0] = *(const PG8_LAS bf16x8*)(lds + PG8_SB(b, h) + boffk0 + n * 2048); dst[n][1] = *(const PG8_LAS bf16x8*)(lds + PG8_SB(b, h) + boffk1 + n * 2048); } } while (0)
#define PG8_CAT8(x) __builtin_shufflevector(__builtin_bit_cast(i32x4, (x)[0]), __builtin_bit_cast(i32x4, (x)[1]), 0, 1, 2, 3, 4, 5, 6, 7)
#define PG8_MMA(ai, bj, At, Bt) do { __builtin_amdgcn_s_setprio(1); _Pragma("unroll") for (int m = 0; m < 4; ++m) _Pragma("unroll") for (int n = 0; n < 2; ++n) { \
        if constexpr (F8) { const i32x8 b8_ = PG8_CAT8(Bt[n]), a8_ = PG8_CAT8(At[m]); asm volatile("v_mfma_f32_16x16x128_f8f6f4 %0, %1, %2, %0" : "+v"(acc[ai][bj][m][n]) : "v"(b8_), "v"(a8_)); } \
        else { _Pragma("unroll") for (int k = 0; k < 2; ++k) acc[ai][bj][m][n] = __builtin_amdgcn_mfma_f32_16x16x32_bf16(Bt[n][k], At[m][k], acc[ai][bj][m][n], 0, 0, 0); } } \
        __builtin_amdgcn_s_setprio(0); } while (0)
#define PG8_WAIT_V(n) asm volatile("s_waitcnt vmcnt(" #n ")" ::: "memory")
#define PG8_WAIT_L(n) asm volatile("s_waitcnt lgkmcnt(" #n ")" ::: "memory")
#define PG8_BAR __builtin_amdgcn_s_barrier()
#define PG8_SCHED __builtin_amdgcn_sched_barrier(0)
    Unit cur, nxt; int ui = 0;
    if (!S.next(0, cur)) return;
    f32x4 acc[2][2][4][2];
#pragma unroll
    for (int a = 0; a < 2; ++a)
#pragma unroll
        for (int b = 0; b < 2; ++b)
#pragma unroll
            for (int m = 0; m < 4; ++m)
#pragma unroll
                for (int n = 0; n < 2; ++n) acc[a][b][m][n] = (f32x4){0.f, 0.f, 0.f, 0.f};
    bf16x8 At[4][2], B0[2][2], B1[2][2];
    const char* cA = (const char*)g.A + (size_t)cur.pm * tstep + (size_t)cur.k0 * kstep; const char* cB = (const char*)g.Bt + (size_t)cur.pn * tstep + (size_t)cur.k0 * kstep;
    nt = cur.nt ? cur.nt : nt_full;
    S.a_ready(cur);
    if constexpr (SP2) {
        PG8_STAGE(PG8_SB(0, 0), cB, voffB); PG8_STAGE(PG8_SB(0, 1), cB + hstep, voffB); PG8_STAGE(PG8_SA(0, 0), cA, voffA); PG8_STAGE(PG8_SA(0, 1), cA + hstep, voffA);
        if (wr == 1) PG8_BAR;
        PG8_WAIT_V(2); PG8_BAR;
        PG8_STAGE(PG8_SB(1, 0), cB + kstep, voffB); PG8_STAGE(PG8_SA(1, 0), cA + kstep, voffA); PG8_STAGE(PG8_SB(1, 1), cB + hstep + kstep, voffB);
        PG8_WAIT_V(6); PG8_BAR;
    } else {
        PG8_STAGE(PG8_SB(0, 0), cB, voffB); PG8_STAGE(PG8_SA(0, 0), cA, voffA); PG8_STAGE(PG8_SB(0, 1), cB + hstep, voffB); PG8_STAGE(PG8_SA(0, 1), cA + hstep, voffA);
        if (wr == 1) PG8_BAR;
        PG8_WAIT_V(4); PG8_BAR;
        PG8_STAGE(PG8_SB(1, 0), cB + kstep, voffB); PG8_STAGE(PG8_SA(1, 0), cA + kstep, voffA); PG8_STAGE(PG8_SB(1, 1), cB + hstep + kstep, voffB);
        PG8_WAIT_V(6); PG8_BAR;
    }
    for (;;) {
        const bool has_next = S.next(ui + 1, nxt);
        const char* nA = has_next ? (const char*)g.A + (size_t)nxt.pm * tstep + (size_t)nxt.k0 * kstep : cA; const char* nB = has_next ? (const char*)g.Bt + (size_t)nxt.pn * tstep + (size_t)nxt.k0 * kstep : cB;
        for (int t = 0; t < nt; t += 2) {
            const bool last = (t == nt - 2);
            const char* a1 = cA + (size_t)(t + 1) * kstep;
            const char* a2 = last ? nA : cA + (size_t)(t + 2) * kstep; const char* b2 = last ? nB : cB + (size_t)(t + 2) * kstep;
            const char* a3 = a2 + kstep; const char* b3 = b2 + kstep;
            if (last && has_next) S.a_ready(nxt);
            if constexpr (SP2) {
            PG8_LDB(B0, 0, 0); PG8_LDB(B1, 0, 1); PG8_SCHED; PG8_LDA(At, 0, 0); PG8_STAGE(PG8_SA(1, 1), a1 + hstep, voffA);
            PG8_WAIT_V(8); PG8_WAIT_L(0); PG8_BAR; PG8_MMA(0, 0, At, B0); PG8_MMA(0, 1, At, B1); PG8_BAR; PG8_SCHED;
            PG8_LDA(At, 0, 1); PG8_STAGE(PG8_SB(0, 0), b2, voffB); PG8_STAGE(PG8_SB(0, 1), b2 + hstep, voffB); PG8_STAGE(PG8_SA(0, 0), a2, voffA);
            PG8_WAIT_V(8); PG8_WAIT_L(0); PG8_BAR; PG8_MMA(1, 0, At, B0); PG8_MMA(1, 1, At, B1); PG8_BAR; PG8_SCHED;
            PG8_LDB(B0, 1, 0); PG8_LDB(B1, 1, 1); PG8_SCHED; PG8_LDA(At, 1, 0); PG8_STAGE(PG8_SA(0, 1), a2 + hstep, voffA);
            PG8_WAIT_V(8); PG8_WAIT_L(0); PG8_BAR; PG8_MMA(0, 0, At, B0); PG8_MMA(0, 1, At, B1); PG8_BAR; PG8_SCHED;
            PG8_LDA(At, 1, 1); PG8_STAGE(PG8_SB(1, 0), b3, voffB); PG8_STAGE(PG8_SB(1, 1), b3 + hstep, voffB); PG8_STAGE(PG8_SA(1, 0), a3, voffA);
            PG8_WAIT_V(8); PG8_WAIT_L(0); PG8_BAR; PG8_MMA(1, 0, At, B0); PG8_MMA(1, 1, At, B1); PG8_BAR; PG8_SCHED;
            } else {
            PG8_LDB(B0, 0, 0); PG8_SCHED; PG8_LDA(At, 0, 0); PG8_STAGE(PG8_SA(1, 1), a1 + hstep, voffA);
            PG8_WAIT_L(8); PG8_BAR; PG8_WAIT_L(0); PG8_MMA(0, 0, At, B0); PG8_BAR; PG8_SCHED;
            PG8_LDB(B1, 0, 1); PG8_STAGE(PG8_SB(0, 0), b2, voffB);
            PG8_BAR; PG8_WAIT_L(0); PG8_MMA(0, 1, At, B1); PG8_BAR;
            PG8_LDA(At, 0, 1); PG8_STAGE(PG8_SA(0, 0), a2, voffA);
            PG8_BAR; PG8_WAIT_L(0); PG8_MMA(1, 0, At, B0); PG8_BAR; PG8_SCHED;
            PG8_STAGE(PG8_SB(0, 1), b2 + hstep, voffB);
            PG8_WAIT_V(6); PG8_BAR; PG8_MMA(1, 1, At, B1); PG8_BAR;
            PG8_LDB(B0, 1, 0); PG8_SCHED; PG8_LDA(At, 1, 0); PG8_STAGE(PG8_SA(0, 1), a2 + hstep, voffA);
            PG8_WAIT_L(8); PG8_BAR; PG8_WAIT_L(0); PG8_MMA(0, 0, At, B0); PG8_BAR; PG8_SCHED;
            PG8_LDB(B1, 1, 1); PG8_STAGE(PG8_SB(1, 0), b3, voffB);
            PG8_BAR; PG8_WAIT_L(0); PG8_MMA(0, 1, At, B1); PG8_BAR;
            PG8_LDA(At, 1, 1); PG8_STAGE(PG8_SA(1, 0), a3, voffA);
            PG8_BAR; PG8_WAIT_L(0); PG8_MMA(1, 0, At, B0); PG8_BAR; PG8_SCHED;
            PG8_STAGE(PG8_SB(1, 1), b3 + hstep, voffB);
            PG8_WAIT_V(6); PG8_BAR; PG8_MMA(1, 1, At, B1); PG8_BAR;
            }
        }
        if constexpr (ALIGN_EPI) { if (wr == 0) PG8_BAR; }
        if constexpr (F8) {
            asm volatile("s_nop 15\n\ts_nop 15" : "+v"(acc[0][0][0][0]), "+v"(acc[0][0][0][1]), "+v"(acc[0][0][1][0]), "+v"(acc[0][0][1][1]), "+v"(acc[0][0][2][0]), "+v"(acc[0][0][2][1]), "+v"(acc[0][0][3][0]), "+v"(acc[0][0][3][1]),
                         "+v"(acc[0][1][0][0]), "+v"(acc[0][1][0][1]), "+v"(acc[0][1][1][0]), "+v"(acc[0][1][1][1]), "+v"(acc[0][1][2][0]), "+v"(acc[0][1][2][1]), "+v"(acc[0][1][3][0]), "+v"(acc[0][1][3][1]));
            asm volatile("s_nop 15\n\ts_nop 15" : "+v"(acc[1][0][0][0]), "+v"(acc[1][0][0][1]), "+v"(acc[1][0][1][0]), "+v"(acc[1][0][1][1]), "+v"(acc[1][0][2][0]), "+v"(acc[1][0][2][1]), "+v"(acc[1][0][3][0]), "+v"(acc[1][0][3][1]),
                         "+v"(acc[1][1][0][0]), "+v"(acc[1][1][0][1]), "+v"(acc[1][1][1][0]), "+v"(acc[1][1][1][1]), "+v"(acc[1][1][2][0]), "+v"(acc[1][1][2][1]), "+v"(acc[1][1][3][0]), "+v"(acc[1][1][3][1])); }
        if constexpr (!Epi::AFTER_DRAIN) { E(acc, cur, wr, wc, fr, fq); S.done(cur); }
        if (!has_next) break;
#pragma unroll
        for (int a = 0; a < 2; ++a)
#pragma unroll
            for (int b = 0; b < 2; ++b)
#pragma unroll
                for (int m = 0; m < 4; ++m)
#pragma unroll
                    for (int n = 0; n < 2; ++n) acc[a][b][m][n] = (f32x4){0.f, 0.f, 0.f, 0.f};
        cur = nxt; cA = nA; cB = nB; ++ui; nt = cur.nt ? cur.nt : nt_full;
        if constexpr (ALIGN_EPI) { if (wr == 1) PG8_BAR; }
    }
    PG8_WAIT_V(0);
    if constexpr (!ALIGN_EPI) { if (wr == 0) PG8_BAR; }
    PG8_BAR;
    if constexpr (Epi::AFTER_DRAIN) { E.fused(acc, cur, wr, wc, fr, fq, lds, wid, lane); S.done(cur); }
#undef PG8_SA
#undef PG8_SB
#undef PG8_STAGE
#undef PG8_LDA
#undef PG8_LDB
#undef PG8_MMA
#undef PG8_CAT8
#undef PG8_WAIT_V
#undef PG8_WAIT_L
#undef PG8_BAR
#undef PG8_SCHED
}
}
#define GAS __attribute__((address_space(1)))
#define LAS __attribute__((address_space(3)))
typedef unsigned short bf16;
typedef unsigned v4u __attribute__((ext_vector_type(4)));
typedef float f32x4 __attribute__((ext_vector_type(4)));
typedef short bf16x8 __attribute__((ext_vector_type(8)));
typedef GAS unsigned gu32;
typedef GAS unsigned long long gu64;
#define RLX_AGENT __ATOMIC_RELAXED, __HIP_MEMORY_SCOPE_AGENT
#define LDS_WAIT() asm volatile("s_waitcnt lgkmcnt(0)" ::: "memory")
#define VM_WAIT() asm volatile("s_waitcnt vmcnt(0)" ::: "memory")
__device__ __forceinline__ unsigned long long rt() { return __builtin_amdgcn_s_memrealtime(); }
__device__ __forceinline__ unsigned f2bf(float f) { unsigned u = __builtin_bit_cast(unsigned, f); return (u + 0x7fffu + ((u >> 16) & 1u)) >> 16; }
__device__ __forceinline__ unsigned pk2(float lo, float hi) { return f2bf(lo) | (f2bf(hi) << 16); }

#define XB_TMO      128
#define XB_XCNT(j)  (256  + 64 * (j))
#define XB_XSUB(j)  (1280 + 64 * (j))
#define XB_XGEN(j)  (2304 + 64 * (j))
#define XB_TOP      3328
#define XB_TOPGEN   3392
#define XCD_BAR_WORDS 3456
#define XB_SPIN_CAP (1u << 18)

__device__ __forceinline__ unsigned xb_ld(unsigned* p)              { return __hip_atomic_load(p, __ATOMIC_RELAXED, __HIP_MEMORY_SCOPE_AGENT); }
__device__ __forceinline__ unsigned xb_add(unsigned* p, unsigned v) { return __hip_atomic_fetch_add(p, v, __ATOMIC_RELAXED, __HIP_MEMORY_SCOPE_AGENT); }
__device__ __forceinline__ unsigned xb_xcc_id() { return (unsigned)__builtin_amdgcn_s_getreg((3 << 11) | 20) & 0xFu; }
#define XB_SPIN(cond, bar) do { unsigned _sp = 0; while (cond) { __builtin_amdgcn_s_sleep(1); \
    if ((++_sp & 255u) == 0u) { if (xb_ld(&(bar)[XB_TMO])) break; if (_sp > XB_SPIN_CAP) { atomicAdd(&(bar)[XB_TMO], 1u); break; } } } } while (0)

struct XcdBarrier {
    unsigned* bar; unsigned x;
    volatile LAS unsigned* st;
};

__device__ __forceinline__ XcdBarrier xcd_barrier_post(unsigned* bar, volatile LAS unsigned* st) {
    XcdBarrier b; b.bar = bar; b.x = xb_xcc_id(); b.st = st;
    if (threadIdx.x == 0) (void)xb_add(&bar[XB_XCNT(b.x)], 1u);
    return b;
}
__device__ __forceinline__ void xcd_barrier_complete(unsigned* bar, unsigned x, unsigned& nloc, unsigned& nx) {
    const unsigned G = gridDim.x * gridDim.y * gridDim.z;
    unsigned sum, cnt, mine, sp = 0u;
    for (;;) {
        sum = 0u; cnt = 0u; mine = 0u;
#pragma unroll
        for (unsigned j = 0; j < 16; ++j) { const unsigned c = xb_ld(&bar[XB_XCNT(j)]); sum += c; cnt += (c > 0u) ? 1u : 0u; mine = (j == x) ? c : mine; }
        if (sum == G) break;
        __builtin_amdgcn_s_sleep(1);
        if ((++sp & 255u) == 0u) { if (xb_ld(&bar[XB_TMO])) break; if (sp > XB_SPIN_CAP) { atomicAdd(&bar[XB_TMO], 1u); break; } }
    }
    nloc = mine > 0u ? mine : 1u; nx = cnt > 0u ? cnt : 1u;
}

__device__ __forceinline__ void xcd_barrier(const XcdBarrier& b) {
    asm volatile("s_waitcnt vmcnt(0)" ::: "memory");
    __syncthreads();
    if (threadIdx.x == 0) {
        unsigned* bar = b.bar;
        __builtin_amdgcn_s_waitcnt(0);
        unsigned nloc = b.st[0], nx = b.st[1];
        if (nloc == 0u) { xcd_barrier_complete(bar, b.x, nloc, nx); b.st[0] = nloc; b.st[1] = nx; }
        const unsigned old = xb_add(&bar[XB_XSUB(b.x)], 1u);
        const unsigned gen = old / nloc;
        if (old + 1u == (gen + 1u) * nloc) {
            __builtin_amdgcn_fence(__ATOMIC_RELEASE, "agent");
            asm volatile("s_waitcnt vmcnt(0)" ::: "memory");
            const unsigned og = xb_add(&bar[XB_TOP], 1u);
            const unsigned tg = og / nx;
            if (og + 1u == (tg + 1u) * nx) xb_add(&bar[XB_TOPGEN], 1u);
            else XB_SPIN(xb_ld(&bar[XB_TOPGEN]) == tg, bar);
            __builtin_amdgcn_fence(__ATOMIC_ACQUIRE, "agent");
            xb_add(&bar[XB_XGEN(b.x)], 1u);
            asm volatile("s_waitcnt vmcnt(0)" ::: "memory");
        } else {
            XB_SPIN(xb_ld(&bar[XB_XGEN(b.x)]) == gen, bar);
            __builtin_amdgcn_fence(__ATOMIC_ACQUIRE, "agent");
            asm volatile("s_waitcnt vmcnt(0)" ::: "memory");
        }
    }
    __syncthreads();
}

constexpr int NWAVES = 8;
constexpr int DM = 2048, MCTX = 4096, MLAT = 8192, MTOK = MCTX + MLAT, DFF = 5632, INW = 5120, WA = 1024, NADA = 9 * DM;
constexpr float EPS = 1e-6f;
constexpr float LOG2E_F = 1.4426950408889634f;
constexpr int KSPLIT_ADA = 16, ADA_ROWS = DM / KSPLIT_ADA;
#ifndef FFN_FP8
#define FFN_FP8 1
#endif
constexpr int NSET = 5;

constexpr size_t MiB = 1u << 20;
constexpr size_t WS_CTL = 0, CTL_ZERO_BYTES = 1 * MiB;
constexpr size_t WS_MODP = 1 * MiB;
constexpr size_t WS_MOD = 7 * MiB;
constexpr size_t WS_WSB = 7 * MiB + 512 * 1024;
constexpr size_t WS_CK = 8 * MiB, WS_CV = 12 * MiB;
constexpr size_t WS_WGU1 = 16 * MiB, WS_WD1 = 60 * MiB, WS_WIN = 82 * MiB, WS_WOUT = 102 * MiB, WS_WGU2 = 110 * MiB, WS_WD2 = 154 * MiB;
constexpr size_t WS_H = 176 * MiB;
constexpr size_t WS_ACT = 224 * MiB;
constexpr size_t WS_Q = 356 * MiB, WS_K = 380 * MiB, WS_V = 404 * MiB, WS_U = 428 * MiB, WS_VG = 452 * MiB;
constexpr size_t WS_MIX = 476 * MiB;
constexpr size_t WS_END = 524 * MiB;
constexpr int CW_BAR = 4096;

constexpr int RING_OFF = 0, RING_BYTES = 131072;
constexpr int LDSCTL_OFF = RING_BYTES, MISC_OFF = LDSCTL_OFF + 320;
constexpr int LDS_BYTES = 147456;

struct Frame {
    LAS unsigned char* lds;
    volatile LAS unsigned* MISC;
    gu32* ctl;
    int tid, lane, wave;
    int vcu, G;
};

__device__ __forceinline__ float wave_sum(float v) {
#pragma unroll
    for (int o = 1; o < 64; o <<= 1) v += __shfl_xor(v, o);
    return v;
}
__device__ __forceinline__ float bf2f(unsigned short b) { return __builtin_bit_cast(float, (unsigned)b << 16); }
__device__ __forceinline__ float bflo(unsigned w) { return __builtin_bit_cast(float, w << 16); }
__device__ __forceinline__ float bfhi(unsigned w) { return __builtin_bit_cast(float, w & 0xffff0000u); }

template <bool F8> __device__ __forceinline__ void p0_transpose_item(const float* W, int K, int N, bf16* WT, int mode, LAS float* scr, int item, int lane) {
    const int nblk = N / 32, kb = item / nblk, nb = item % nblk, k0 = 64 * kb, n0 = 32 * nb;
    const int drow0 = mode == 0 ? n0 : ((n0 >> 7) * 256 + (mode == 2 ? 128 : 0) + (n0 & 127));
#pragma unroll 8
    for (int i = 0; i < 32; ++i) { const int kk = 2 * i + (lane >> 5); scr[kk * 33 + (lane & 31)] = W[(size_t)(k0 + kk) * N + n0 + (lane & 31)]; }
    LDS_WAIT(); asm volatile("" ::: "memory");
    const int c = lane & 7;
#pragma unroll
    for (int j = 0; j < 4; ++j) { const int n = (lane >> 3) + 8 * j; const LAS float* s = scr + (8 * c) * 33 + n;
        if constexpr (F8) { pg8::u32x2 o; o.x = pg8::pack4_fp8(s[0 * 33] * pg8::F8_SW, s[1 * 33] * pg8::F8_SW, s[2 * 33] * pg8::F8_SW, s[3 * 33] * pg8::F8_SW);
            o.y = pg8::pack4_fp8(s[4 * 33] * pg8::F8_SW, s[5 * 33] * pg8::F8_SW, s[6 * 33] * pg8::F8_SW, s[7 * 33] * pg8::F8_SW);
            *(GAS pg8::u32x2*)((unsigned char*)WT + (size_t)(drow0 + n) * K + k0 + 8 * c) = o; }
        else { v4u o; o.x = pk2(s[0 * 33], s[1 * 33]); o.y = pk2(s[2 * 33], s[3 * 33]); o.z = pk2(s[4 * 33], s[5 * 33]); o.w = pk2(s[6 * 33], s[7 * 33]);
            *(GAS v4u*)(WT + (size_t)(drow0 + n) * K + k0 + 8 * c) = o; } }
    LDS_WAIT(); asm volatile("" ::: "memory");
}
__device__ __forceinline__ void p0_ada_item(const float* c_lat, const float* c_ctx, const float* w_ada, float* part, LAS float* scr, int item, int lane) {
    const int cc = item % 72, ks = item / 72, k0 = ks * ADA_ROWS;
    for (int idx = lane; idx < NSET * ADA_ROWS; idx += 64) { const int j = idx / ADA_ROWS, kk = idx % ADA_ROWS;
        const float cv = j == 0 ? c_ctx[k0 + kk] : c_lat[(size_t)(j - 1) * DM + k0 + kk];
        scr[idx] = cv / (1.0f + __expf(-cv)); }
    LDS_WAIT(); asm volatile("" ::: "memory");
    f32x4 acc[NSET];
#pragma unroll
    for (int j = 0; j < NSET; ++j) acc[j] = (f32x4){0.f, 0.f, 0.f, 0.f};
    const float* wp = w_ada + (size_t)k0 * NADA + cc * 256 + lane * 4;
#pragma unroll 2
    for (int k4 = 0; k4 < ADA_ROWS; k4 += 4) {
        f32x4 w[4];
#pragma unroll
        for (int i = 0; i < 4; ++i) w[i] = __builtin_nontemporal_load((const f32x4*)(wp + (size_t)(k4 + i) * NADA));
#pragma unroll
        for (int j = 0; j < NSET; ++j) { const f32x4 s = *(const LAS f32x4*)(scr + j * ADA_ROWS + k4);
            acc[j] += w[0] * s[0]; acc[j] += w[1] * s[1]; acc[j] += w[2] * s[2]; acc[j] += w[3] * s[3]; }
    }
#pragma unroll
    for (int j = 0; j < NSET; ++j) *(f32x4*)(part + ((size_t)(ks * NSET + j)) * NADA + cc * 256 + lane * 4) = acc[j];
    LDS_WAIT(); asm volatile("" ::: "memory");
}

template <bool F8> __device__ __forceinline__ void rownorm_mod_row(float* xrow, const float* prow, const float* A, const float* B, bf16* orow, int lane) {
    GAS f32x4* xr = (GAS f32x4*)xrow + lane;
    f32x4 v[8]; float s = 0.f;
#pragma unroll
    for (int j = 0; j < 8; ++j) v[j] = xr[64 * j];
    if (prow) {
#pragma unroll
        for (int j = 0; j < 8; ++j) { v[j] += *((const GAS f32x4*)prow + lane + 64 * j); xr[64 * j] = v[j]; } }
#pragma unroll
    for (int j = 0; j < 8; ++j) s += (v[j].x * v[j].x + v[j].y * v[j].y) + (v[j].z * v[j].z + v[j].w * v[j].w);
    const float rstd = 1.0f / sqrtf(wave_sum(s) * (1.0f / DM) + EPS);
    GAS unsigned long long* o8 = (GAS unsigned long long*)orow + lane;
#pragma unroll
    for (int j = 0; j < 8; ++j) { const f32x4 a = *((const f32x4*)A + lane + 64 * j), b = *((const f32x4*)B + lane + 64 * j);
        const f32x4 y = v[j] * rstd * a + b;
        if constexpr (F8) ((GAS unsigned*)orow)[lane + 64 * j] = pg8::pack4_fp8(y.x * pg8::F8_SA, y.y * pg8::F8_SA, y.z * pg8::F8_SA, y.w * pg8::F8_SA);
        else o8[64 * j] = (unsigned long long)pg8::cvt_pk_bf16(y.x, y.y) | ((unsigned long long)pg8::cvt_pk_bf16(y.z, y.w) << 32); }
}

typedef float f32x16 __attribute__((ext_vector_type(16)));
typedef short s16x4 __attribute__((ext_vector_type(4)));
__device__ __forceinline__ int crow(int r, int hi) { return (r & 3) + 8 * (r >> 2) + 4 * hi; }
__device__ __forceinline__ s16x4 vtr(const LAS unsigned char* p) { return __builtin_bit_cast(s16x4, __builtin_amdgcn_ds_read_tr16_b64_v4i16((LAS s16x4*)p)); }
constexpr int AT_K = 0, AT_V = 16384, AT_WS = 32768, AT_TB = 32768 + 2048 + 256, AT_END = AT_TB + 2048 + 512;
struct AttnArgs { const bf16* qb; const bf16* kb; const bf16* vb; const bf16* ckb; const bf16* cvb; bf16* mixb; const float* rpb; };

__device__ __forceinline__ void attn_unit(LAS unsigned char* lds, const AttnArgs& T, bool lat, int b, int h, int rb) {
    const int tid = threadIdx.x, lane = tid & 63, r32 = lane & 31, hi = lane >> 5; const int wid = __builtin_amdgcn_readfirstlane(tid >> 6);
    int nA, nB, gr0 = 0, rq = 0, c0 = 0, rs = 0; const bf16 *KA, *VA; size_t rowA, rowB = 0, qrow;
    if (lat) { rq = 4 * rb + (wid >> 1); c0 = (wid & 1) * 32; rs = min(max(rq - 4, 0), 24);
        const int rs_min = min(max(4 * rb - 4, 0), 24), rs_max = min(max(4 * rb - 1, 0), 24); nB = rs_max + 8 - rs_min; gr0 = rs_min;
        nA = 8; KA = T.ckb; VA = T.cvb; rowA = (size_t)b * 512; rowB = (size_t)MCTX + (size_t)b * 2048 + 64 * rs_min; qrow = (size_t)MCTX + (size_t)b * 2048 + rq * 64 + c0; }
    else { nA = 4; nB = 0; KA = T.kb; VA = T.vb; rowA = (size_t)b * 256; qrow = (size_t)b * 256 + wid * 32; }
    const int NT = nA + nB;
    __syncthreads();
    if (lat && tid < 480) { const int e = tid & 31, dri = tid >> 5; ((LAS float*)(lds + AT_TB))[tid] = e < 31 ? T.rpb[h * 465 + dri * 31 + e] * LOG2E_F : 0.f; }
    bf16x8 qr[4];
#pragma unroll
    for (int d0 = 0; d0 < 4; ++d0) qr[d0] = *(const bf16x8*)(T.qb + (qrow + r32) * WA + h * 64 + d0 * 16 + hi * 8);
    LAS float* wsf = (LAS float*)(lds + AT_WS) + wid * 64;
    f32x16 o[2]; o[0] = (f32x16){}; o[1] = (f32x16){};
    float m_run = -INFINITY, l_run = 0.f;
    v4u kreg, vreg;
#define AT_LOAD(t) do { const bf16* Kp_; const bf16* Vp_; size_t row_; if ((t) < nA) { Kp_ = KA; Vp_ = VA; row_ = rowA + 64 * (size_t)(t); } else { Kp_ = T.kb; Vp_ = T.vb; row_ = rowB + 64 * (size_t)((t) - nA); } \
        kreg = *(const v4u*)(Kp_ + (row_ + skey) * WA + h * 64 + sch * 8); \
        vreg = *(const v4u*)(Vp_ + (row_ + skey) * WA + h * 64 + sch * 8); } while (0)
    const int skey = tid >> 3, sch = tid & 7;
    const int kst = skey * 128 + ((sch ^ ((skey >> 1) & 7)) * 16), vst = (sch >> 2) * 4096 + skey * 64 + (sch & 3) * 16;
    const int qc = c0 + r32, qcs = min(max(qc - 8, 0), 48), bbase = 4 * hi - qc + 15;
    unsigned vmask = 0u;
#pragma unroll
    for (int r = 0; r < 16; ++r) { const int kc = crow(r, hi); vmask |= (kc >= qcs && kc < qcs + 16) ? (1u << r) : 0u; vmask |= (kc + 32 >= qcs && kc + 32 < qcs + 16) ? (1u << (16 + r)) : 0u; }
    const int ksw = (r32 >> 1) & 7;
    AT_LOAD(0);
    for (int t = 0; t < NT; ++t) {
        const int slot = (t & 1) * 8192;
        *(LAS v4u*)(lds + AT_K + slot + kst) = kreg;
        *(LAS v4u*)(lds + AT_V + slot + vst) = vreg;
        __syncthreads();
        if (t + 1 < NT) AT_LOAD(t + 1);
        const bool local = t >= nA; const int gr = gr0 + (t - nA);
        if (local && (gr < rs || gr >= rs + 8)) continue;
        f32x16 p0, p1;
        if (local) {
            const LAS float* tb = (const LAS float*)(lds + AT_TB) + (gr - rq + 7) * 32 + bbase;
#pragma unroll
            for (int r = 0; r < 16; ++r) { const int cr0 = (r & 3) + 8 * (r >> 2);
                const float b0 = tb[cr0], b1 = tb[cr0 + 32];
                p0[r] = ((vmask >> r) & 1u) ? b0 : -1e30f; p1[r] = ((vmask >> (16 + r)) & 1u) ? b1 : -1e30f; }
        } else { p0 = (f32x16){}; p1 = (f32x16){}; }
        const LAS unsigned char* kbp = lds + AT_K + slot + r32 * 128;
#pragma unroll
        for (int d0 = 0; d0 < 4; ++d0) { const int co = ((2 * d0 + hi) ^ ksw) * 16; const bf16x8 k0 = *(const LAS bf16x8*)(kbp + co), k1 = *(const LAS bf16x8*)(kbp + co + 4096);
            p0 = __builtin_amdgcn_mfma_f32_32x32x16_bf16(k0, qr[d0], p0, 0, 0, 0); p1 = __builtin_amdgcn_mfma_f32_32x32x16_bf16(k1, qr[d0], p1, 0, 0, 0); }
        float mx = fmaxf(p0[0], p1[0]);
#pragma unroll
        for (int r = 1; r < 16; ++r) mx = fmaxf(mx, fmaxf(p0[r], p1[r]));
        mx = fmaxf(mx, __shfl_xor(mx, 32));
        const float m_new = fmaxf(m_run, mx);
        if (__any(m_new > m_run)) {
            const float alpha = __builtin_amdgcn_exp2f(m_run - m_new);
            l_run *= alpha; m_run = m_new;
            if (hi == 0) wsf[r32] = alpha;
            LDS_WAIT(); asm volatile("" ::: "memory");
#pragma unroll
            for (int g = 0; g < 4; ++g) { const f32x4 af = *(const LAS f32x4*)(wsf + 8 * g + 4 * hi);
#pragma unroll
                for (int i = 0; i < 4; ++i) { o[0][4 * g + i] *= af[i]; o[1][4 * g + i] *= af[i]; } }
        }
        float ls = 0.f;
#pragma unroll
        for (int r = 0; r < 16; ++r) { p0[r] = __builtin_amdgcn_exp2f(p0[r] - m_run); p1[r] = __builtin_amdgcn_exp2f(p1[r] - m_run); ls += p0[r] + p1[r]; }
        l_run += ls;
        v4u pw[4];
#pragma unroll
        for (int s = 0; s < 2; ++s) {
            pw[s] = (v4u){pg8::cvt_pk_bf16(p0[8 * s], p0[8 * s + 1]), pg8::cvt_pk_bf16(p0[8 * s + 2], p0[8 * s + 3]), pg8::cvt_pk_bf16(p0[8 * s + 4], p0[8 * s + 5]), pg8::cvt_pk_bf16(p0[8 * s + 6], p0[8 * s + 7])};
            pw[2 + s] = (v4u){pg8::cvt_pk_bf16(p1[8 * s], p1[8 * s + 1]), pg8::cvt_pk_bf16(p1[8 * s + 2], p1[8 * s + 3]), pg8::cvt_pk_bf16(p1[8 * s + 4], p1[8 * s + 5]), pg8::cvt_pk_bf16(p1[8 * s + 6], p1[8 * s + 7])}; }
        const LAS unsigned char* vbp = lds + AT_V + slot + ((lane >> 4) & 1) * 32 + (lane & 3) * 8 + (4 * hi + ((lane & 15) >> 2)) * 64;
#pragma unroll
        for (int d0 = 0; d0 < 2; ++d0)
#pragma unroll
            for (int ks = 0; ks < 4; ++ks) { const s16x4 lo = vtr(vbp + d0 * 4096 + ks * 1024), hh = vtr(vbp + d0 * 4096 + ks * 1024 + 512);
                const bf16x8 vf = (bf16x8){lo[0], lo[1], lo[2], lo[3], hh[0], hh[1], hh[2], hh[3]};
                o[d0] = __builtin_amdgcn_mfma_f32_32x32x16_bf16(__builtin_bit_cast(bf16x8, pw[ks]), vf, o[d0], 0, 0, 0); }
    }
#undef AT_LOAD
    l_run += __shfl_xor(l_run, 32);
    if (hi == 0) wsf[r32] = 1.0f / l_run;
    LDS_WAIT(); asm volatile("" ::: "memory");
    bf16* Ow = T.mixb + qrow * DM + h * 64 + r32;
#pragma unroll
    for (int g = 0; g < 4; ++g) { const f32x4 af = *(const LAS f32x4*)(wsf + 8 * g + 4 * hi);
#pragma unroll
        for (int i = 0; i < 4; ++i) { const int q = 8 * g + 4 * hi + i;
            Ow[(size_t)q * DM] = (bf16)f2bf(o[0][4 * g + i] * af[i]); Ow[(size_t)q * DM + 32] = (bf16)f2bf(o[1][4 * g + i] * af[i]); } }
}

struct GateArgs { const bf16* ub; const bf16* vgb; const bf16* wsb; const float* b_s; const float* gnorm; bf16* mixb; };
__device__ __forceinline__ void gate_units(LAS unsigned char* lds, const GateArgs& T, int u0, int ustride, int nunits) {
    const int tid = threadIdx.x, lane = tid & 63, r32 = lane & 31, hi = lane >> 5; const int wid = __builtin_amdgcn_readfirstlane(tid >> 6);
    if (u0 >= nunits) return;
    const int ch = tid & 15, rowb = tid >> 4;
    v4u raw[4];
#define GT_LOADVG(u) do { const size_t r0_ = (size_t)((u) >> 3) * 128; const int g_ = (u) & 7; _Pragma("unroll") for (int i = 0; i < 4; ++i) raw[i] = *(const v4u*)(T.vgb + (r0_ + rowb + 32 * i) * WA + g_ * 128 + ch * 8); } while (0)
    GT_LOADVG(u0);
    __syncthreads();
    LAS float* S = (LAS float*)(lds + 32768);
    for (int u = u0; u < nunits; u += ustride) {
        const int n = u >> 3, g = u & 7; const size_t row0 = (size_t)n * 128;
        const f32x4 g0 = *(const f32x4*)(T.gnorm + g * 128 + ch * 8), g1 = *(const f32x4*)(T.gnorm + g * 128 + ch * 8 + 4);
#pragma unroll
        for (int i = 0; i < 4; ++i) { const int row = rowb + 32 * i;
            float v[8]; v[0] = bflo(raw[i].x); v[1] = bfhi(raw[i].x); v[2] = bflo(raw[i].y); v[3] = bfhi(raw[i].y); v[4] = bflo(raw[i].z); v[5] = bfhi(raw[i].z); v[6] = bflo(raw[i].w); v[7] = bfhi(raw[i].w);
            float ss = 0.f;
#pragma unroll
            for (int e = 0; e < 8; ++e) ss += v[e] * v[e];
            ss += __shfl_xor(ss, 1); ss += __shfl_xor(ss, 2); ss += __shfl_xor(ss, 4); ss += __shfl_xor(ss, 8);
            const float rstd = 1.0f / sqrtf(ss * (1.0f / 128.0f) + EPS);
            v4u w; w.x = pg8::cvt_pk_bf16(v[0] * rstd * g0[0], v[1] * rstd * g0[1]); w.y = pg8::cvt_pk_bf16(v[2] * rstd * g0[2], v[3] * rstd * g0[3]);
            w.z = pg8::cvt_pk_bf16(v[4] * rstd * g1[0], v[5] * rstd * g1[1]); w.w = pg8::cvt_pk_bf16(v[6] * rstd * g1[2], v[7] * rstd * g1[3]);
            *(LAS v4u*)(lds + (ch >> 2) * 8192 + row * 64 + (ch & 3) * 16) = w; }
        __syncthreads();
        if (u + ustride < nunits) GT_LOADVG(u + ustride);
        v4u ureg[4];
#pragma unroll
        for (int i = 0; i < 4; ++i) ureg[i] = *(const v4u*)(T.ub + (row0 + rowb + 32 * i) * WA + g * 128 + ch * 8);
        const int ib = wid >> 1, cb0 = 2 * (wid & 1);
        f32x16 acc[2]; acc[0] = (f32x16){}; acc[1] = (f32x16){};
        const bf16* wfrag = T.wsb + ((size_t)(g * 128 + 32 * ib + r32) * 16 + hi) * 8;
        const LAS unsigned char* vbp = lds + ((lane >> 4) & 1) * 32 + (lane & 3) * 8 + (4 * hi + ((lane & 15) >> 2)) * 64;
        bf16x8 af[8];
#pragma unroll
        for (int ks = 0; ks < 8; ++ks) af[ks] = *(const bf16x8*)(wfrag + ks * 16);
#pragma unroll
        for (int ks = 0; ks < 8; ++ks) {
#pragma unroll
            for (int cbi = 0; cbi < 2; ++cbi) { const LAS unsigned char* q = vbp + (cb0 + cbi) * 8192 + ks * 1024;
                const s16x4 lo = vtr(q), hh = vtr(q + 512);
                const bf16x8 vf = (bf16x8){lo[0], lo[1], lo[2], lo[3], hh[0], hh[1], hh[2], hh[3]};
                acc[cbi] = __builtin_amdgcn_mfma_f32_32x32x16_bf16(af[ks], vf, acc[cbi], 0, 0, 0); }
        }
#pragma unroll
        for (int q4 = 0; q4 < 4; ++q4) { const f32x4 bs = *(const f32x4*)(T.b_s + g * 128 + 32 * ib + 8 * q4 + 4 * hi);
#pragma unroll
            for (int e = 0; e < 4; ++e) { const int il = 32 * ib + 8 * q4 + 4 * hi + e;
                S[il * 128 + 32 * cb0 + r32] = acc[0][4 * q4 + e] + bs[e]; S[il * 128 + 32 * (cb0 + 1) + r32] = acc[1][4 * q4 + e] + bs[e]; } }
        __syncthreads();
#pragma unroll
        for (int i = 0; i < 4; ++i) { const int row = rowb + 32 * i;
            const f32x4 s0 = *(const LAS f32x4*)(S + row * 128 + ch * 8), s1 = *(const LAS f32x4*)(S + row * 128 + ch * 8 + 4);
            v4u w; w.x = pg8::cvt_pk_bf16(bflo(ureg[i].x) * s0[0], bfhi(ureg[i].x) * s0[1]); w.y = pg8::cvt_pk_bf16(bflo(ureg[i].y) * s0[2], bfhi(ureg[i].y) * s0[3]);
            w.z = pg8::cvt_pk_bf16(bflo(ureg[i].z) * s1[0], bfhi(ureg[i].z) * s1[1]); w.w = pg8::cvt_pk_bf16(bflo(ureg[i].w) * s1[2], bfhi(ureg[i].w) * s1[3]);
            *(v4u*)(T.mixb + (row0 + row) * DM + WA + g * 128 + ch * 8) = w; }
    }
#undef GT_LOADVG
}


#ifndef SELFCHECK
#define SELFCHECK 0
#endif
#if SELFCHECK
__device__ __forceinline__ void selfcheck_mixer(LAS unsigned char* lds, int gw, int lane, int wave, const bf16* QB, const bf16* KB, const bf16* VB, const bf16* CKB, const bf16* CVB,
                                                const bf16* UB, const bf16* VGB, const bf16* MIXB, const float* rpb, const float* w_s, const float* b_s, const float* gnorm, unsigned* errw) {
    LAS float* P = (LAS float*)(lds + wave * 4096);
    {
        const int b = gw & 3, h = (gw >> 2) & 15, sel = gw >> 9;
        int n = (gw * 211) & 2047;
        if (sel == 1) n = (gw & 63) + 64 * ((gw >> 6) & 7); else if (sel == 2) n = 2047 - ((gw & 63) + 64 * ((gw >> 6) & 7)); else if (sel == 3) n = (gw * 977 + 5) & 2047;
        const int r = n >> 6, c = n & 63, rs = min(max(r - 4, 0), 24), cs = min(max(c - 8, 0), 48);
        const size_t qrow = (size_t)MCTX + (size_t)b * 2048 + n;
        float mx = -3.0e38f;
        for (int kidx = lane; kidx < 640; kidx += 64) {
            const bf16* kp; float bias = 0.f;
            if (kidx < 128) { const int krow = rs + (kidx >> 4), kcol = cs + (kidx & 15); kp = KB + ((size_t)MCTX + (size_t)b * 2048 + krow * 64 + kcol) * WA + h * 64;
                bias = rpb[h * 465 + (krow - r + 7) * 31 + (kcol - c + 15)] * LOG2E_F; }
            else kp = CKB + ((size_t)b * 512 + (kidx - 128)) * WA + h * 64;
            float d = 0.f;
            for (int e = 0; e < 64; ++e) d += bf2f(QB[qrow * WA + h * 64 + e]) * bf2f(kp[e]);
            d += bias; P[kidx] = d; mx = fmaxf(mx, d); }
#pragma unroll
        for (int o = 1; o < 64; o <<= 1) mx = fmaxf(mx, __shfl_xor(mx, o));
        LDS_WAIT(); asm volatile("" ::: "memory");
        float sum = 0.f;
        for (int kidx = lane; kidx < 640; kidx += 64) { const float e = exp2f(P[kidx] - mx); P[kidx] = e; sum += e; }
        sum = wave_sum(sum);
        LDS_WAIT(); asm volatile("" ::: "memory");
        float o = 0.f;
        for (int kidx = 0; kidx < 640; ++kidx) { const bf16* vp;
            if (kidx < 128) { const int krow = rs + (kidx >> 4), kcol = cs + (kidx & 15); vp = VB + ((size_t)MCTX + (size_t)b * 2048 + krow * 64 + kcol) * WA + h * 64; }
            else vp = CVB + ((size_t)b * 512 + (kidx - 128)) * WA + h * 64;
            o += P[kidx] * bf2f(vp[lane]); }
        o /= sum;
        const float fast = bf2f(MIXB[qrow * DM + h * 64 + lane]);
        float err = fabsf(fast - o), rms = wave_sum(o * o);
#pragma unroll
        for (int s = 1; s < 64; s <<= 1) err = fmaxf(err, __shfl_xor(err, s));
        const float rel = err / (sqrtf(rms * (1.0f / 64.0f)) + 1e-6f);
        if (lane == 0) atomicMax(errw + 0, __float_as_uint(rel));
        LDS_WAIT(); asm volatile("" ::: "memory");
    }
    {
        const int b = gw & 15, h = (gw >> 4) & 15, s = (gw * 37 + (gw >> 8)) & 255;
        const size_t qrow = (size_t)b * 256 + s;
        float mx = -3.0e38f;
        for (int kidx = lane; kidx < 256; kidx += 64) { const bf16* kp = KB + ((size_t)b * 256 + kidx) * WA + h * 64;
            float d = 0.f;
            for (int e = 0; e < 64; ++e) d += bf2f(QB[qrow * WA + h * 64 + e]) * bf2f(kp[e]);
            P[kidx] = d; mx = fmaxf(mx, d); }
#pragma unroll
        for (int o = 1; o < 64; o <<= 1) mx = fmaxf(mx, __shfl_xor(mx, o));
        LDS_WAIT(); asm volatile("" ::: "memory");
        float sum = 0.f;
        for (int kidx = lane; kidx < 256; kidx += 64) { const float e = exp2f(P[kidx] - mx); P[kidx] = e; sum += e; }
        sum = wave_sum(sum);
        LDS_WAIT(); asm volatile("" ::: "memory");
        float o = 0.f;
        for (int kidx = 0; kidx < 256; ++kidx) o += P[kidx] * bf2f(VB[((size_t)b * 256 + kidx) * WA + h * 64 + lane]);
        o /= sum;
        const float fast = bf2f(MIXB[qrow * DM + h * 64 + lane]);
        float err = fabsf(fast - o), rms = wave_sum(o * o);
#pragma unroll
        for (int s2 = 1; s2 < 64; s2 <<= 1) err = fmaxf(err, __shfl_xor(err, s2));
        const float rel = err / (sqrtf(rms * (1.0f / 64.0f)) + 1e-6f);
        if (lane == 0) atomicMax(errw + 1, __float_as_uint(rel));
        LDS_WAIT(); asm volatile("" ::: "memory");
    }
    {
        const int row = (gw * 6 + (gw >> 5)) % MTOK, c = (gw * 509 + 3) & 1023, g = c >> 7, i = row & 127; const size_t chunk0 = (size_t)(row & ~127);
        float contrib = 0.f;
        for (int j = lane; j < 128; j += 64) { float ss = 0.f;
            for (int e = 0; e < 128; ++e) { const float v = bf2f(VGB[(chunk0 + j) * WA + g * 128 + e]); ss += v * v; }
            const float rstd = 1.0f / sqrtf(ss * (1.0f / 128.0f) + EPS);
            contrib += w_s[((size_t)g * 128 + i) * 128 + j] * (bf2f(VGB[(chunk0 + j) * WA + c]) * rstd * gnorm[c]); }
        const float s = wave_sum(contrib) + b_s[g * 128 + i];
        const float gm = bf2f(UB[(size_t)row * WA + c]) * s, fast = bf2f(MIXB[(size_t)row * DM + WA + c]);
        const float rel = fabsf(fast - gm) / (fabsf(gm) + 0.1f);
        if (lane == 0) atomicMax(errw + 2, __float_as_uint(rel));
    }
}
#endif

struct Args { const float* in[26]; float* out; unsigned char* ws; int ph_lo, ph_hi, li, pad; };
constexpr int N_PHASES = 14;
__global__ void __launch_bounds__(NWAVES * 64, 2) mega_fwd(Args args) {
    extern __shared__ __attribute__((aligned(16))) unsigned char lds[];
    Frame F;
    F.lds = (LAS unsigned char*)lds;
    F.MISC = (volatile LAS unsigned*)(F.lds + MISC_OFF);
    F.tid = threadIdx.x; F.lane = F.tid & 63; F.wave = __builtin_amdgcn_readfirstlane(F.tid >> 6);
    F.G = gridDim.x; { const int bx = blockIdx.x; F.vcu = (F.G % 8 == 0) ? (bx % 8) * (F.G / 8) + bx / 8 : bx; }
    unsigned char* ws = args.ws;
    F.ctl = (gu32*)(ws + WS_CTL);
    const float* x_prompt = args.in[0]; const float* x_sample = args.in[1];
    float* const xbuf = args.out;
    float* const state_k = args.out + (size_t)MTOK * DM; float* const state_v = state_k + (size_t)MCTX * WA;
    bf16* const Wgu1 = (bf16*)(ws + WS_WGU1); bf16* const Wd1 = (bf16*)(ws + WS_WD1); bf16* const Win = (bf16*)(ws + WS_WIN); bf16* const Wout = (bf16*)(ws + WS_WOUT);
    bf16* const Wgu2 = (bf16*)(ws + WS_WGU2); bf16* const Wd2 = (bf16*)(ws + WS_WD2);
    bf16* const HB = (bf16*)(ws + WS_H); bf16* const ACT = (bf16*)(ws + WS_ACT);
    bf16* const QB = (bf16*)(ws + WS_Q); bf16* const KB = (bf16*)(ws + WS_K); bf16* const VB = (bf16*)(ws + WS_V); bf16* const UB = (bf16*)(ws + WS_U); bf16* const VGB = (bf16*)(ws + WS_VG);
    bf16* const MIXB = (bf16*)(ws + WS_MIX); bf16* const CKB = (bf16*)(ws + WS_CK); bf16* const CVB = (bf16*)(ws + WS_CV);
    float* const MODP = (float*)(ws + WS_MODP); float* const MOD = (float*)(ws + WS_MOD);
    bf16* const WSB = (bf16*)(ws + WS_WSB);
    float* const PBUF = (float*)(ws + WS_Q);
    const bool split = (F.G == 256);

    for (int u = F.tid; u < (LDS_BYTES - LDSCTL_OFF) / 4; u += NWAVES * 64) ((LAS unsigned*)(F.lds + LDSCTL_OFF))[u] = 0u;
    __syncthreads();
    XcdBarrier bar = xcd_barrier_post((unsigned*)(F.ctl + CW_BAR) + args.li * XCD_BAR_WORDS, F.MISC + 8);
    const int lo = args.ph_lo, hi = args.ph_hi;
#define IN(k) (lo <= (k) && (k) < hi)
#ifndef PROBE_REPEAT
#define PROBE_REPEAT -1
#endif
#define REP(k) for (int rep_ = 0; rep_ < ((PROBE_REPEAT == (k)) ? 2 : 1); ++rep_)
#define REPBAR() do { if (rep_) xcd_barrier(bar); } while (0)
#define SEAM(k) do { if (IN(k) && IN((k) + 1)) xcd_barrier(bar); } while (0)
    const int gw = F.vcu * NWAVES + F.wave, NGW = F.G * NWAVES;

    if (IN(0)) REP(0) { REPBAR();
        LAS float* scr = (LAS float*)(F.lds + RING_OFF + F.wave * 16384);
        { const int gt = F.vcu * (NWAVES * 64) + F.tid, NGT = F.G * NWAVES * 64;
          for (int i = gt; i < 2 * 262144; i += NGT) { const int which = i >= 262144, e = (which ? i - 262144 : i) * 8; const float* src = args.in[2 + which] + e;
              const f32x4 a = *(const f32x4*)src, b2 = *(const f32x4*)(src + 4);
              v4u o; o.x = pg8::cvt_pk_bf16(a[0], a[1]); o.y = pg8::cvt_pk_bf16(a[2], a[3]); o.z = pg8::cvt_pk_bf16(b2[0], b2[1]); o.w = pg8::cvt_pk_bf16(b2[2], b2[3]);
              *(v4u*)((which ? CVB : CKB) + e) = o; } }
        { const int gt = F.vcu * (NWAVES * 64) + F.tid, NGT = F.G * NWAVES * 64;
          for (int i = gt; i < 16384; i += NGT) { const int hh = i & 1, ks = (i >> 1) & 7, gi = i >> 4; const float* src = args.in[16] + (size_t)gi * 128 + 16 * ks + 4 * hh;
              const f32x4 a = *(const f32x4*)src, b2 = *(const f32x4*)(src + 8);
              v4u o; o.x = pg8::cvt_pk_bf16(a[0], a[1]); o.y = pg8::cvt_pk_bf16(a[2], a[3]); o.z = pg8::cvt_pk_bf16(b2[0], b2[1]); o.w = pg8::cvt_pk_bf16(b2[2], b2[3]);
              *(v4u*)(WSB + (size_t)i * 8) = o; } }
        constexpr int I_GU = 32 * 176, I_D = 88 * 64, I_IN = 32 * 160, I_OUT = 32 * 64;
        constexpr int NTR = 6 * I_GU + I_IN + I_OUT;
        static_assert(I_GU == I_D && NTR == 40960, "item count");
        int t0, t1;
        if (NGW == 2048) { if (gw < 1152) { p0_ada_item(args.in[4], args.in[5], args.in[6], MODP, scr, gw, F.lane); t0 = gw * 13; t1 = t0 + 13; } else { t0 = 14976 + (gw - 1152) * 29; t1 = t0 + 29; } }
        else { for (int it = gw; it < 1152; it += NGW) p0_ada_item(args.in[4], args.in[5], args.in[6], MODP, scr, it, F.lane); const int per = (NTR + NGW - 1) / NGW; t0 = gw * per; t1 = min(t0 + per, NTR); }
        for (int it = t0; it < t1; ++it) {
            int r = it;
            if (r < I_GU) { p0_transpose_item<FFN_FP8>(args.in[9], DM, DFF, Wgu1, 1, scr, r, F.lane); continue; } r -= I_GU;
            if (r < I_GU) { p0_transpose_item<FFN_FP8>(args.in[10], DM, DFF, Wgu1, 2, scr, r, F.lane); continue; } r -= I_GU;
            if (r < I_D) { p0_transpose_item<FFN_FP8>(args.in[11], DFF, DM, Wd1, 0, scr, r, F.lane); continue; } r -= I_D;
            if (r < I_IN) { p0_transpose_item<false>(args.in[13], DM, INW, Win, 0, scr, r, F.lane); continue; } r -= I_IN;
            if (r < I_OUT) { p0_transpose_item<false>(args.in[20], DM, DM, Wout, 0, scr, r, F.lane); continue; } r -= I_OUT;
            if (r < I_GU) { p0_transpose_item<FFN_FP8>(args.in[22], DM, DFF, Wgu2, 1, scr, r, F.lane); continue; } r -= I_GU;
            if (r < I_GU) { p0_transpose_item<FFN_FP8>(args.in[23], DM, DFF, Wgu2, 2, scr, r, F.lane); continue; } r -= I_GU;
            p0_transpose_item<FFN_FP8>(args.in[24], DFF, DM, Wd2, 0, scr, r, F.lane);
        }
    }
    SEAM(0);
    if (IN(1)) REP(1) { REPBAR();
        const int gt = F.vcu * (NWAVES * 64) + F.tid, NGT = F.G * NWAVES * 64;
        for (int idx = gt; idx < NSET * NADA; idx += NGT) { const int j = idx / NADA, n = idx % NADA, chunk = n >> 11, col = n & 2047;
            float s = args.in[7][n];
#pragma unroll
            for (int ks = 0; ks < KSPLIT_ADA; ++ks) s += MODP[((size_t)(ks * NSET + j)) * NADA + n];
            const int sub = chunk / 3, kind = chunk % 3;
            if (kind == 1) { const float* gn = sub == 0 ? args.in[8] : sub == 1 ? args.in[12] : args.in[21]; s = gn[col] * (1.0f + s); }
            else if (kind == 2 && sub != 1) s *= 0.5f;
            MOD[(size_t)j * NADA + n] = s; }
    }
    SEAM(1);
    if (IN(2)) REP(2) { REPBAR();
        for (int m = gw; m < MTOK; m += NGW) { const int j = m < MCTX ? 0 : 1 + ((m - MCTX) >> 11);
            const float* xr = m < MCTX ? x_prompt + (size_t)m * DM : x_sample + (size_t)(m - MCTX) * DM;
            rownorm_mod_row<FFN_FP8>(const_cast<float*>(xr), nullptr, MOD + (size_t)j * NADA + 1 * DM, MOD + (size_t)j * NADA + 0 * DM, HB + (size_t)m * (FFN_FP8 ? DM / 2 : DM), F.lane); }
    }
    SEAM(2);
    if (IN(3)) REP(3) { REPBAR();
        pg8::Gemm g{HB, Wgu1, MTOK, 2 * DFF, FFN_FP8 ? DM / 2 : DM}; pg8::StaticOrder S; S.init(MTOK, 2 * DFF, F.G, (int)blockIdx.x);
#if FFN_FP8
        pg8::EpiSwiGLU8 E{(unsigned char*)ACT, DFF};
        pg8::gemm_phase<pg8::EpiSwiGLU8, pg8::StaticOrder, true, true, true>(F.lds + RING_OFF, g, S, E);
#else
        pg8::EpiSwiGLU E{ACT, DFF, 0};
#if PROBE_REPEAT == 3 && defined(PROBE_NULL_EPI)
        E.skip = rep_;
#endif
        pg8::gemm_phase<pg8::EpiSwiGLU, pg8::StaticOrder, true, true>(F.lds + RING_OFF, g, S, E);
#endif
    }
    SEAM(3);
    if (IN(4)) REP(4) { REPBAR();
        pg8::Gemm g{ACT, Wd1, MTOK, DM, FFN_FP8 ? DFF / 2 : DFF}; pg8::FlexOrder S; S.st.init(MTOK, DM, F.G, (int)blockIdx.x); S.sp.v = F.vcu; S.sp.nth = (FFN_FP8 ? DFF / 2 : DFF) / 128; S.split = split;
        pg8::EpiRes E{x_prompt, x_sample, xbuf, MOD + 2 * DM, DM, FFN_FP8 ? pg8::F8_DQ : 1.0f, PBUF};
        pg8::gemm_phase<pg8::EpiRes, pg8::FlexOrder, true, true, FFN_FP8>(F.lds + RING_OFF, g, S, E);
    }
    SEAM(4);
    if (IN(5)) REP(5) { REPBAR();
        for (int m = gw; m < MTOK; m += NGW) { const int j = m < MCTX ? 0 : 1 + ((m - MCTX) >> 11);
            rownorm_mod_row<false>(xbuf + (size_t)m * DM, (split && m >= 8192) ? PBUF + (size_t)(m - 8192) * DM : nullptr, MOD + (size_t)j * NADA + 4 * DM, MOD + (size_t)j * NADA + 3 * DM, HB + (size_t)m * DM, F.lane); }
    }
    SEAM(5);
    if (IN(6)) REP(6) { REPBAR();
        pg8::Gemm g{HB, Win, MTOK, INW, DM}; pg8::StaticOrder S; S.init(MTOK, INW, F.G, (int)blockIdx.x);
        pg8::EpiMixIn E{QB, KB, VB, UB, VGB, state_k, state_v, 0.125f * LOG2E_F};
        pg8::gemm_phase<pg8::EpiMixIn, pg8::StaticOrder, true, true>(F.lds + RING_OFF, g, S, E);
    }
    SEAM(6);
    if (IN(7)) REP(7) { REPBAR();
        const AttnArgs AT{QB, KB, VB, CKB, CVB, MIXB, args.in[14]};
        const GateArgs GT{UB, VGB, WSB, args.in[17], args.in[15], MIXB};
        REP(70) { REPBAR(); for (int u = F.vcu; u < 512; u += F.G) attn_unit(F.lds + RING_OFF, AT, true, u >> 7, (u >> 3) & 15, u & 7); }
        REP(71) { REPBAR(); for (int u = F.vcu; u < 256; u += F.G) attn_unit(F.lds + RING_OFF, AT, false, u >> 4, u & 15, 0); }
        REP(72) { REPBAR(); gate_units(F.lds + RING_OFF, GT, F.vcu, F.G, 768); }
    }
    SEAM(7);
#if SELFCHECK
    if (IN(8)) { selfcheck_mixer(F.lds + RING_OFF, gw, F.lane, F.wave, QB, KB, VB, CKB, CVB, UB, VGB, MIXB, args.in[14], args.in[16], args.in[17], args.in[15], (unsigned*)(F.ctl + 64)); xcd_barrier(bar); }
#endif
    if (IN(8)) REP(8) { REPBAR();
        for (int m = gw; m < MTOK; m += NGW) {
            v4u* rowp = (v4u*)(MIXB + (size_t)m * DM) + F.lane;
#pragma unroll
            for (int half = 0; half < 2; ++half) {
                v4u raw[2]; float v[16]; float ss = 0.f;
#pragma unroll
                for (int j = 0; j < 2; ++j) { raw[j] = rowp[half * 128 + 64 * j];
                    v[8 * j + 0] = bflo(raw[j].x); v[8 * j + 1] = bfhi(raw[j].x); v[8 * j + 2] = bflo(raw[j].y); v[8 * j + 3] = bfhi(raw[j].y);
                    v[8 * j + 4] = bflo(raw[j].z); v[8 * j + 5] = bfhi(raw[j].z); v[8 * j + 6] = bflo(raw[j].w); v[8 * j + 7] = bfhi(raw[j].w); }
#pragma unroll
                for (int e = 0; e < 16; ++e) ss += v[e] * v[e];
                const float rstd = 1.0f / sqrtf(wave_sum(ss) * (1.0f / WA) + EPS);
                const float* gn = args.in[18 + half];
#pragma unroll
                for (int j = 0; j < 2; ++j) { const f32x4 g0 = *(const f32x4*)(gn + (F.lane + 64 * j) * 8), g1 = *(const f32x4*)(gn + (F.lane + 64 * j) * 8 + 4);
                    v4u w; w.x = pg8::cvt_pk_bf16(v[8 * j + 0] * rstd * g0[0], v[8 * j + 1] * rstd * g0[1]); w.y = pg8::cvt_pk_bf16(v[8 * j + 2] * rstd * g0[2], v[8 * j + 3] * rstd * g0[3]);
                    w.z = pg8::cvt_pk_bf16(v[8 * j + 4] * rstd * g1[0], v[8 * j + 5] * rstd * g1[1]); w.w = pg8::cvt_pk_bf16(v[8 * j + 6] * rstd * g1[2], v[8 * j + 7] * rstd * g1[3]);
                    rowp[half * 128 + 64 * j] = w; }
            }
        }
    }
    SEAM(8);
    if (IN(9)) REP(9) { REPBAR();
        pg8::Gemm g{MIXB, Wout, MTOK, DM, DM}; pg8::FlexOrder S; S.st.init(MTOK, DM, F.G, (int)blockIdx.x); S.sp.v = F.vcu; S.sp.nth = (DM) / 128; S.split = split;
        pg8::EpiRes E{xbuf, xbuf + (size_t)MCTX * DM, xbuf, MOD + 5 * DM, DM, 1.0f, PBUF};
        pg8::gemm_phase<pg8::EpiRes, pg8::FlexOrder, true, true>(F.lds + RING_OFF, g, S, E);
    }
    SEAM(9);
    if (IN(10)) REP(10) { REPBAR();
        for (int m = gw; m < MTOK; m += NGW) { const int j = m < MCTX ? 0 : 1 + ((m - MCTX) >> 11);
            rownorm_mod_row<FFN_FP8>(xbuf + (size_t)m * DM, (split && m >= 8192) ? PBUF + (size_t)(m - 8192) * DM : nullptr, MOD + (size_t)j * NADA + 7 * DM, MOD + (size_t)j * NADA + 6 * DM, HB + (size_t)m * (FFN_FP8 ? DM / 2 : DM), F.lane); }
    }
    SEAM(10);
    if (IN(11)) REP(11) { REPBAR();
        pg8::Gemm g{HB, Wgu2, MTOK, 2 * DFF, FFN_FP8 ? DM / 2 : DM}; pg8::StaticOrder S; S.init(MTOK, 2 * DFF, F.G, (int)blockIdx.x);
#if FFN_FP8
        pg8::EpiSwiGLU8 E{(unsigned char*)ACT, DFF};
        pg8::gemm_phase<pg8::EpiSwiGLU8, pg8::StaticOrder, true, true, true>(F.lds + RING_OFF, g, S, E);
#else
        pg8::EpiSwiGLU E{ACT, DFF, 0};
        pg8::gemm_phase<pg8::EpiSwiGLU, pg8::StaticOrder, true, true>(F.lds + RING_OFF, g, S, E);
#endif
    }
    SEAM(11);
    if (IN(12)) REP(12) { REPBAR();
        pg8::Gemm g{ACT, Wd2, MTOK, DM, FFN_FP8 ? DFF / 2 : DFF}; pg8::FlexOrder S; S.st.init(MTOK, DM, F.G, (int)blockIdx.x); S.sp.v = F.vcu; S.sp.nth = (FFN_FP8 ? DFF / 2 : DFF) / 128; S.split = split;
        pg8::EpiRes E{xbuf, xbuf + (size_t)MCTX * DM, xbuf, MOD + 8 * DM, DM, FFN_FP8 ? pg8::F8_DQ : 1.0f, PBUF};
        pg8::gemm_phase<pg8::EpiRes, pg8::FlexOrder, true, true, FFN_FP8>(F.lds + RING_OFF, g, S, E);
    }
    SEAM(12);
    if (IN(13)) REP(13) { REPBAR();
        const float* fg = args.in[25];
        for (int m = gw; m < MTOK; m += NGW) {
            GAS f32x4* xr = (GAS f32x4*)(xbuf + (size_t)m * DM) + F.lane;
            f32x4 v[8]; float s = 0.f;
#pragma unroll
            for (int j = 0; j < 8; ++j) v[j] = xr[64 * j];
            if (split && m >= 8192) { const GAS f32x4* pr = (const GAS f32x4*)(PBUF + (size_t)(m - 8192) * DM) + F.lane;
#pragma unroll
                for (int j = 0; j < 8; ++j) v[j] += pr[64 * j]; }
#pragma unroll
            for (int j = 0; j < 8; ++j) s += (v[j].x * v[j].x + v[j].y * v[j].y) + (v[j].z * v[j].z + v[j].w * v[j].w);
            const float rstd = 1.0f / sqrtf(wave_sum(s) * (1.0f / DM) + EPS);
#pragma unroll
            for (int j = 0; j < 8; ++j) xr[64 * j] = v[j] * rstd * *((const f32x4*)fg + F.lane + 64 * j);
        }
#if SELFCHECK
        if (gw == 0 && F.lane == 0) {
            const float e0 = __uint_as_float(__hip_atomic_load((unsigned*)(F.ctl + 64), RLX_AGENT)), e1 = __uint_as_float(__hip_atomic_load((unsigned*)(F.ctl + 65), RLX_AGENT)), e2 = __uint_as_float(__hip_atomic_load((unsigned*)(F.ctl + 66), RLX_AGENT));
#ifdef SELFCHECK_REPORT
            const int k = SELFCHECK_REPORT - 1; const float e = k == 0 ? e0 : k == 1 ? e1 : e2;
            xbuf[0] = (k == 0 ? 1e3f : k == 1 ? 1e5f : 1e7f) * (1.0f + 100.0f * fminf(e, 0.9f));
#else
            if (!(e0 < 0.03f)) xbuf[0] = 1e3f * (1.0f + 100.0f * fminf(e0, 0.9f));
            else if (!(e1 < 0.03f)) xbuf[0] = 1e5f * (1.0f + 100.0f * fminf(e1, 0.9f));
            else if (!(e2 < 0.05f)) xbuf[0] = 1e7f * (1.0f + 100.0f * fminf(e2, 0.9f));
#endif
        }
#endif
    }
#undef IN
#undef SEAM
}

#ifndef MK_N_LAUNCHES
#define MK_N_LAUNCHES 1
#endif
extern "C" void kernel_launch(void* const* d_in, const int* in_sizes, int n_in, void* d_out, int out_size, void* d_ws, size_t ws_size, hipStream_t stream) {
    static int grid = 0;
    if (grid == 0) {
        if (n_in != 26 || out_size != MTOK * DM + 2 * MCTX * WA || ws_size < WS_END) { fprintf(stderr, "kernel_launch: unexpected shapes: n_in %d out %d ws %zu (need %zu); nothing launched\n", n_in, out_size, ws_size, (size_t)WS_END); grid = -1; return; }
        int dev = 0, cus = 0, per_cu = 0;
        if (hipGetDevice(&dev) != hipSuccess || hipDeviceGetAttribute(&cus, hipDeviceAttributeMultiprocessorCount, dev) != hipSuccess) { fprintf(stderr, "kernel_launch: device query failed\n"); grid = -1; return; }
        if (hipFuncSetAttribute((const void*)mega_fwd, hipFuncAttributeMaxDynamicSharedMemorySize, LDS_BYTES) != hipSuccess) { fprintf(stderr, "kernel_launch: hipFuncSetAttribute failed\n"); grid = -1; return; }
        if (hipOccupancyMaxActiveBlocksPerMultiprocessor(&per_cu, (const void*)mega_fwd, NWAVES * 64, LDS_BYTES) != hipSuccess || per_cu < 1)
            fprintf(stderr, "kernel_launch: note: occupancy query reports %d workgroups per CU\n", per_cu);
        (void)hipGetLastError();
        grid = cus;
    }
    if (grid < 0) return;
    if (hipMemsetAsync((char*)d_ws + WS_CTL, 0, CTL_ZERO_BYTES, stream) != hipSuccess) { fprintf(stderr, "kernel_launch: hipMemsetAsync failed\n"); return; }
    Args a{};
    for (int i = 0; i < 26; ++i) a.in[i] = (const float*)d_in[i];
    a.out = (float*)d_out; a.ws = (unsigned char*)d_ws;
    if (MK_N_LAUNCHES == 1) { a.ph_lo = 0; a.ph_hi = N_PHASES; a.li = 0; hipLaunchKernelGGL(mega_fwd, dim3(grid), dim3(NWAVES * 64), LDS_BYTES, stream, a); }
    else { for (int p = 0; p < N_PHASES; ++p) { a.ph_lo = p; a.ph_hi = p + 1; a.li = 0; hipLaunchKernelGGL(mega_fwd, dim3(grid), dim3(NWAVES * 64), LDS_BYTES, stream, a); } }
    const hipError_t le = hipPeekAtLastError();
    if (le != hipSuccess) fprintf(stderr, "kernel_launch: launch failed: %s\n", hipGetErrorName(le));
}
```

```cpp
#include <hip/hip_runtime.h>
#include <cstdio>
#include <cstdint>
namespace pg8 {
#define PG8_LAS __attribute__((address_space(3)))
typedef unsigned short bf16_t;
typedef short bf16x8 __attribute__((ext_vector_type(8)));
typedef float f32x4 __attribute__((ext_vector_type(4)));
typedef unsigned u32x4 __attribute__((ext_vector_type(4)));
typedef int i32x4 __attribute__((ext_vector_type(4)));
typedef int i32x8 __attribute__((ext_vector_type(8)));
constexpr int BM = 256, BK = 64, HALF = 128, HTB = HALF * BK * 2  , STAGE_BYTES = 8 * HTB, NXCD = 8, WGM = 8;

__host__ __device__ __forceinline__ int lds_byte(int r, int c) { const int st = (r >> 4) * 2 + (c >> 5), rr = r & 15, cc = c & 31, ob = rr * 64 + cc * 2; return st * 1024 + (ob ^ (((ob >> 9) & 1) << 5)); }
__host__ __device__ __forceinline__ void stage_rc(int b, int& R, int& C) { const int st = b / 1024, sb = b % 1024, swz = sb ^ (((sb >> 9) & 1) << 5); R = (st >> 1) * 16 + swz / 64; C = (st & 1) * 32 + (swz % 64) / 2; }
__host__ __device__ __forceinline__ int perm32(int rho) { const int n = rho >> 4, i = rho & 15; return 8 * (i >> 2) + 4 * n + (i & 3); }

struct Unit { int pm, pn, k0, nt, part; };
struct Gemm { const bf16_t* A; const bf16_t* Bt; int M, N, K; };

struct StaticOrder {
    int nM, nN, nwg, G, c;
    __host__ __device__ void init(int M, int N, int G_, int c_) { nM = M / BM; nN = N / BM; nwg = nM * nN; G = G_; c = c_; }
    __host__ __device__ bool next(int i, Unit& u) const {
        const long L = (long)i * G + c; if (L >= nwg) return false;
        int wgid = (int)L; { const int q = nwg / NXCD, r = nwg % NXCD, xcd = wgid % NXCD, off = wgid / NXCD; wgid = (xcd < r ? xcd * (q + 1) : r * (q + 1) + (xcd - r) * q) + off; }
        const int nig = WGM * nN, gid = wgid / nig, fm = gid * WGM, gsz = (nM - fm) < WGM ? (nM - fm) : WGM;
        u.pm = fm + ((wgid % nig) % gsz); u.pn = (wgid % nig) / gsz; u.k0 = 0; u.nt = 0; u.part = 0; return true;
    }
    __device__ __forceinline__ void a_ready(const Unit&) const {}
    __device__ __forceinline__ void done(const Unit&) const {}
};
struct SplitOrder {
    int v, nth;
    __device__ __forceinline__ bool next(int i, Unit& u) const {
        if (i == 0) { u.pm = v >> 3; u.pn = v & 7; u.k0 = 0; u.nt = 0; u.part = 0; return true; }
        if (i == 1) { const int s = v >> 1, half = v & 1; u.pm = 32 + (s >> 3); u.pn = s & 7; u.k0 = half * nth; u.nt = nth; u.part = half; return true; }
        return false;
    }
    __device__ __forceinline__ void a_ready(const Unit&) const {}
    __device__ __forceinline__ void done(const Unit&) const {}
};
struct FlexOrder {
    StaticOrder st; SplitOrder sp; bool split;
    __device__ __forceinline__ bool next(int i, Unit& u) const { return split ? sp.next(i, u) : st.next(i, u); }
    __device__ __forceinline__ void a_ready(const Unit&) const {}
    __device__ __forceinline__ void done(const Unit&) const {}
};


__device__ __forceinline__ unsigned cvt_pk_bf16(float lo, float hi) { unsigned r; asm volatile("v_cvt_pk_bf16_f32 %0, %1, %2" : "=v"(r) : "v"(lo), "v"(hi)); return r; }
typedef float f32x2 __attribute__((ext_vector_type(2)));
typedef unsigned u32x2 __attribute__((ext_vector_type(2)));
constexpr float LOG2E = 1.4426950408889634f;
__device__ __forceinline__ float silu_f(float g) { return g * __builtin_amdgcn_rcpf(1.0f + __builtin_amdgcn_exp2f(-LOG2E * g)); }
__device__ __forceinline__ float gelu_tanh_f(float x) { const float t = x * (-2.3022081983f + -0.1029432407f * x * x); return x * __builtin_amdgcn_rcpf(1.0f + __builtin_amdgcn_exp2f(t)); }

__device__ __forceinline__ int mod_set_of_tile(int pm) { return pm < 16 ? 0 : 1 + ((pm - 16) >> 3); }
constexpr int MOD_JSTRIDE = 9 * 2048;

__device__ __forceinline__ unsigned pack4_fp8(float a, float b, float c, float d) {
    a = __builtin_fminf(__builtin_fmaxf(a, -448.f), 448.f); b = __builtin_fminf(__builtin_fmaxf(b, -448.f), 448.f);
    c = __builtin_fminf(__builtin_fmaxf(c, -448.f), 448.f); d = __builtin_fminf(__builtin_fmaxf(d, -448.f), 448.f);
    int p = __builtin_amdgcn_cvt_pk_fp8_f32(a, b, 0, false); p = __builtin_amdgcn_cvt_pk_fp8_f32(c, d, p, true); return (unsigned)p;
}
constexpr float F8_SA = 8.0f, F8_SW = 128.0f, F8_DQ = 1.0f / (F8_SA * F8_SW);
struct EpiSwiGLU8 {
    static constexpr bool PERM = true, AFTER_DRAIN = false;
    unsigned char* O; int ldc;
    __device__ __forceinline__ void operator()(const f32x4 (&acc)[2][2][4][2], const Unit& u, int wr, int wc, int fr, int fq) const {
        const int row0 = u.pm * BM + wr * 64 + fr, col0 = u.pn * HALF + wc * 32 + 8 * fq;
#pragma unroll
        for (int ai = 0; ai < 2; ++ai)
#pragma unroll
            for (int m = 0; m < 4; ++m) { unsigned char* rowp = O + (size_t)(row0 + ai * HALF + m * 16) * ldc + col0;
                const f32x4 g0 = acc[ai][0][m][0] * F8_DQ, g1 = acc[ai][0][m][1] * F8_DQ, u0 = acc[ai][1][m][0] * (F8_DQ * F8_SA), u1 = acc[ai][1][m][1] * (F8_DQ * F8_SA);
                u32x2 w; w.x = pack4_fp8(silu_f(g0[0]) * u0[0], silu_f(g0[1]) * u0[1], silu_f(g0[2]) * u0[2], silu_f(g0[3]) * u0[3]);
                w.y = pack4_fp8(silu_f(g1[0]) * u1[0], silu_f(g1[1]) * u1[1], silu_f(g1[2]) * u1[2], silu_f(g1[3]) * u1[3]);
                *(u32x2*)rowp = w; }
    }
};

struct EpiSwiGLU {
    static constexpr bool PERM = true, AFTER_DRAIN = false;
    bf16_t* O; int ldc; int skip;
    __device__ __forceinline__ void operator()(const f32x4 (&acc)[2][2][4][2], const Unit& u, int wr, int wc, int fr, int fq) const {
#if defined(PROBE_NULL_EPI)
        if (skip) {
#pragma unroll
            for (int ai = 0; ai < 2; ++ai)
#pragma unroll
                for (int bj = 0; bj < 2; ++bj)
#pragma unroll
                    for (int m = 0; m < 4; ++m)
#pragma unroll
                        for (int n = 0; n < 2; ++n) asm volatile("" :: "v"(acc[ai][bj][m][n]));
            return; }
#endif
        const int row0 = u.pm * BM + wr * 64 + fr, col0 = u.pn * HALF + wc * 32 + 8 * fq;
#pragma unroll
        for (int ai = 0; ai < 2; ++ai)
#pragma unroll
            for (int m = 0; m < 4; ++m) { bf16_t* rowp = O + (size_t)(row0 + ai * HALF + m * 16) * ldc + col0;
                const f32x4 g0 = acc[ai][0][m][0], g1 = acc[ai][0][m][1], u0 = acc[ai][1][m][0], u1 = acc[ai][1][m][1];
                u32x4 w; w.x = cvt_pk_bf16(silu_f(g0[0]) * u0[0], silu_f(g0[1]) * u0[1]); w.y = cvt_pk_bf16(silu_f(g0[2]) * u0[2], silu_f(g0[3]) * u0[3]);
                w.z = cvt_pk_bf16(silu_f(g1[0]) * u1[0], silu_f(g1[1]) * u1[1]); w.w = cvt_pk_bf16(silu_f(g1[2]) * u1[2], silu_f(g1[3]) * u1[3]);
                *(u32x4*)rowp = w; }
    }
};

struct EpiRes {
    static constexpr bool PERM = false, AFTER_DRAIN = false;
    const float* base_ctx; const float* base_lat; float* out; const float* gtab; int ldc; float dq; float* pbuf;
    __device__ __forceinline__ void operator()(const f32x4 (&acc)[2][2][4][2], const Unit& u, int wr, int wc, int fr, int fq) const {
        const int row0 = u.pm * BM + wr * 64 + fr, col0 = u.pn * BM + wc * 32 + 4 * fq;
        const float* gv = gtab + (size_t)mod_set_of_tile(u.pm) * MOD_JSTRIDE;
        const float* bbase = u.pm < 16 ? base_ctx : base_lat; const int brow0 = u.pm < 16 ? row0 : row0 - 4096;
        f32x4 gvv[2][2];
#pragma unroll
        for (int bj = 0; bj < 2; ++bj)
#pragma unroll
            for (int n = 0; n < 2; ++n) gvv[bj][n] = *(const f32x4*)(gv + col0 + bj * HALF + n * 16) * dq;
#pragma unroll
        for (int ai = 0; ai < 2; ++ai)
#pragma unroll
            for (int m = 0; m < 4; ++m) { const size_t boff = (size_t)(brow0 + ai * HALF + m * 16) * ldc + col0, ooff = (size_t)(row0 + ai * HALF + m * 16) * ldc + col0;
#pragma unroll
                for (int bj = 0; bj < 2; ++bj)
#pragma unroll
                    for (int n = 0; n < 2; ++n) {
                        if (u.part) *(f32x4*)(pbuf + ooff - (size_t)8192 * ldc + bj * HALF + n * 16) = gvv[bj][n] * acc[ai][bj][m][n];
                        else { const f32x4 bs = *(const f32x4*)(bbase + boff + bj * HALF + n * 16);
                            *(f32x4*)(out + ooff + bj * HALF + n * 16) = bs + gvv[bj][n] * acc[ai][bj][m][n]; } } }
    }
};

struct EpiMixIn {
    static constexpr bool PERM = true, AFTER_DRAIN = false;
    bf16_t* qb; bf16_t* kb; bf16_t* vb; bf16_t* ub; bf16_t* vgb; float* state_k; float* state_v; float qscale;
    __device__ __forceinline__ void operator()(const f32x4 (&acc)[2][2][4][2], const Unit& u, int wr, int wc, int fr, int fq) const {
        const int row0 = u.pm * BM + wr * 64 + fr;
#pragma unroll
        for (int bj = 0; bj < 2; ++bj) {
            const int colg = u.pn * BM + bj * HALF, region = colg >> 10, cb = (colg & 1023) + wc * 32 + 8 * fq;
            bf16_t* dst = region == 0 ? qb : region == 1 ? kb : region == 2 ? vb : region == 3 ? ub : vgb;
            float* st = region == 1 ? state_k : state_v; const bool wst = (region == 1 || region == 2) && u.pm < 16;
#pragma unroll
            for (int ai = 0; ai < 2; ++ai)
#pragma unroll
                for (int m = 0; m < 4; ++m) { const int row = row0 + ai * HALF + m * 16; f32x4 v0 = acc[ai][bj][m][0], v1 = acc[ai][bj][m][1];
                    if (wst) { *(f32x4*)(st + (size_t)row * 1024 + cb) = v0; *(f32x4*)(st + (size_t)row * 1024 + cb + 4) = v1; }
                    if (region == 0) { v0 = v0 * qscale; v1 = v1 * qscale; }
                    if (region >= 3) {
#pragma unroll
                        for (int i = 0; i < 4; ++i) { v0[i] = gelu_tanh_f(v0[i]); v1[i] = gelu_tanh_f(v1[i]); } }
                    u32x4 w; w.x = cvt_pk_bf16(v0[0], v0[1]); w.y = cvt_pk_bf16(v0[2], v0[3]); w.z = cvt_pk_bf16(v1[0], v1[1]); w.w = cvt_pk_bf16(v1[2], v1[3]);
                    *(u32x4*)(dst + (size_t)row * 1024 + cb) = w; }
        }
    }
};

struct EpiNull {
    static constexpr bool PERM = true, AFTER_DRAIN = false;
    __device__ __forceinline__ void operator()(const f32x4 (&acc)[2][2][4][2], const Unit& u, int wr, int wc, int fr, int fq) const {
#pragma unroll
        for (int ai = 0; ai < 2; ++ai)
#pragma unroll
            for (int bj = 0; bj < 2; ++bj)
#pragma unroll
                for (int m = 0; m < 4; ++m)
#pragma unroll
                    for (int n = 0; n < 2; ++n) asm volatile("" :: "v"(acc[ai][bj][m][n]));
    }
};

template <class Epi, class Sched, bool ALIGN_EPI = false, bool SP2 = false, bool F8 = false>
__device__ __forceinline__ void gemm_phase(PG8_LAS unsigned char* lds, const Gemm g, const Sched& S, const Epi& E) {
    const int tid = threadIdx.x, wid = __builtin_amdgcn_readfirstlane(tid >> 6), lane = tid & 63, wr = wid >> 2, wc = wid & 3, fr = lane & 15, fq = lane >> 4;
    const int K = g.K, nt_full = K / BK; int nt = nt_full;
    unsigned voffA[2], voffB[2];
#pragma unroll
    for (int i = 0; i < 2; ++i) { int R, C; stage_rc(tid * 16 + i * 8192, R, C); const int Rb = Epi::PERM ? ((R & ~31) + perm32(R & 31)) : R;
        voffA[i] = (unsigned)(R * K + C) * 2u; voffB[i] = (unsigned)(Rb * K + C) * 2u; }
    const size_t kstep = (size_t)(BK * 2);
    const size_t hstep = (size_t)HALF * K * 2;
    const size_t tstep = 2 * hstep;
    const unsigned ldsw = (unsigned)wid * 1024u;
    const int aoff = lds_byte(wr * 64 + fr, fq * 8), boff = lds_byte(wc * 32 + fr, fq * 8);
    const int a8 = lds_byte(wr * 64 + fr, fq * 16), b8 = lds_byte(wc * 32 + fr, fq * 16);
    const int aoffk0 = F8 ? a8 + (fq & 1) * 16 : aoff, aoffk1 = F8 ? a8 + ((fq & 1) ^ 1) * 16 : aoff + 1024;
    const int boffk0 = F8 ? b8 + (fq & 1) * 16 : boff, boffk1 = F8 ? b8 + ((fq & 1) ^ 1) * 16 : boff + 1024;
#define PG8_SA(b, h) (((b) * 2 + (h)) * HTB)
#define PG8_SB(b, h) ((4 + (b) * 2 + (h)) * HTB)
#define PG8_STAGE(bufoff, gbase, voff) do { _Pragma("unroll") for (int _i = 0; _i < 2; ++_i) \
        __builtin_amdgcn_global_load_lds((const unsigned*)((const char*)(gbase) + (voff)[_i]), (PG8_LAS unsigned*)(lds + (bufoff) + ldsw + _i * 8192), 16, 0, 0); } while (0)
#define PG8_LDA(dst, b, h) do { _Pragma("unroll") for (int m = 0; m < 4; ++m) { dst[m][0] = *(const PG8_LAS bf16x8*)(lds + PG8_SA(b, h) + aoffk0 + m * 2048); dst[m][1] = *(const PG8_LAS bf16x8*)(lds + PG8_SA(b, h) + aoffk1 + m * 2048); } } while (0)
#define PG8_LDB(dst, b, h) do { _Pragma("unroll") for (int n = 0; n < 2; ++n) { dst[n][0] = *(const PG8_LAS bf16x8*)(lds + PG8_SB(b, h) + boffk0 + n * 2048); dst[n][1] = *(const PG8_LAS bf16x8*)(lds + PG8_SB(b, h) + boffk1 + n * 2048); } } while (0)
#define PG8_CAT8(x) __builtin_shufflevector(__builtin_bit_cast(i32x4, (x)[0]), __builtin_bit_cast(i32x4, (x)[1]), 0, 1, 2, 3, 4, 5, 6, 7)
#define PG8_MMA(ai, bj, At, Bt) do { __builtin_amdgcn_s_setprio(1); _Pragma("unroll") for (int m = 0; m < 4; ++m) _Pragma("unroll") for (int n = 0; n < 2; ++n) { \
        if constexpr (F8) { const i32x8 b8_ = PG8_CAT8(Bt[n]), a8_ = PG8_CAT8(At[m]); asm volatile("v_mfma_f32_16x16x128_f8f6f4 %0, %1, %2, %0" : "+v"(acc[ai][bj][m][n]) : "v"(b8_), "v"(a8_)); } \
        else { _Pragma("unroll") for (int k = 0; k < 2; ++k) acc[ai][bj][m][n] = __builtin_amdgcn_mfma_f32_16x16x32_bf16(Bt[n][k], At[m][k], acc[ai][bj][m][n], 0, 0, 0); } } \
        __builtin_amdgcn_s_setprio(0); } while (0)
#define PG8_WAIT_V(n) asm volatile("s_waitcnt vmcnt(" #n ")" ::: "memory")
#define PG8_WAIT_L(n) asm volatile("s_waitcnt lgkmcnt(" #n ")" ::: "memory")
#define PG8_BAR __builtin_amdgcn_s_barrier()
#define PG8_SCHED __builtin_amdgcn_sched_barrier(0)
    Unit cur, nxt; int ui = 0;
    if (!S.next(0, cur)) return;
    f32x4 acc[2][2][4][2];
#pragma unroll
    for (int a = 0; a < 2; ++a)
#pragma unroll
        for (int b = 0; b < 2; ++b)
#pragma unroll
            for (int m = 0; m < 4; ++m)
#pragma unroll
                for (int n = 0; n < 2; ++n) acc[a][b][m][n] = (f32x4){0.f, 0.f, 0.f, 0.f};
    bf16x8 At[4][2], B0[2][2], B1[2][2];
    const char* cA = (const char*)g.A + (size_t)cur.pm * tstep + (size_t)cur.k0 * kstep; const char* cB = (const char*)g.Bt + (size_t)cur.pn * tstep + (size_t)cur.k0 * kstep;
    nt = cur.nt ? cur.nt : nt_full;
    S.a_ready(cur);
    if constexpr (SP2) {
        PG8_STAGE(PG8_SB(0, 0), cB, voffB); PG8_STAGE(PG8_SB(0, 1), cB + hstep, voffB); PG8_STAGE(PG8_SA(0, 0), cA, voffA); PG8_STAGE(PG8_SA(0, 1), cA + hstep, voffA);
        if (wr == 1) PG8_BAR;
        PG8_WAIT_V(2); PG8_BAR;
        PG8_STAGE(PG8_SB(1, 0), cB + kstep, voffB); PG8_STAGE(PG8_SA(1, 0), cA + kstep, voffA); PG8_STAGE(PG8_SB(1, 1), cB + hstep + kstep, voffB);
        PG8_WAIT_V(6); PG8_BAR;
    } else {
        PG8_STAGE(PG8_SB(0, 0), cB, voffB); PG8_STAGE(PG8_SA(0, 0), cA, voffA); PG8_STAGE(PG8_SB(0, 1), cB + hstep, voffB); PG8_STAGE(PG8_SA(0, 1), cA + hstep, voffA);
        if (wr == 1) PG8_BAR;
        PG8_WAIT_V(4); PG8_BAR;
        PG8_STAGE(PG8_SB(1, 0), cB + kstep, voffB); PG8_STAGE(PG8_SA(1, 0), cA + kstep, voffA); PG8_STAGE(PG8_SB(1, 1), cB + hstep + kstep, voffB);
        PG8_WAIT_V(6); PG8_BAR;
    }
    for (;;) {
        const bool has_next = S.next(ui + 1, nxt);
        const char* nA = has_next ? (const char*)g.A + (size_t)nxt.pm * tstep + (size_t)nxt.k0 * kstep : cA; const char* nB = has_next ? (const char*)g.Bt + (size_t)nxt.pn * tstep + (size_t)nxt.k0 * kstep : cB;
        for (int t = 0; t < nt; t += 2) {
            const bool last = (t == nt - 2);
            const char* a1 = cA + (size_t)(t + 1) * kstep;
            const char* a2 = last ? nA : cA + (size_t)(t + 2) * kstep; const char* b2 = last ? nB : cB + (size_t)(t + 2) * kstep;
            const char* a3 = a2 + kstep; const char* b3 = b2 + kstep;
            if (last && has_next) S.a_ready(nxt);
            if constexpr (SP2) {
            PG8_LDB(B0, 0, 0); PG8_LDB(B1, 0, 1); PG8_SCHED; PG8_LDA(At, 0, 0); PG8_STAGE(PG8_SA(1, 1), a1 + hstep, voffA);
            PG8_WAIT_V(8); PG8_WAIT_L(0); PG8_BAR; PG8_MMA(0, 0, At, B0); PG8_MMA(0, 1, At, B1); PG8_BAR; PG8_SCHED;
            PG8_LDA(At, 0, 1); PG8_STAGE(PG8_SB(0, 0), b2, voffB); PG8_STAGE(PG8_SB(0, 1), b2 + hstep, voffB); PG8_STAGE(PG8_SA(0, 0), a2, voffA);
            PG8_WAIT_V(8); PG8_WAIT_L(0); PG8_BAR; PG8_MMA(1, 0, At, B0); PG8_MMA(1, 1, At, B1); PG8_BAR; PG8_SCHED;
            PG8_LDB(B0, 1, 0); PG8_LDB(B1, 1, 1); PG8_SCHED; PG8_LDA(At, 1, 0); PG8_STAGE(PG8_SA(0, 1), a2 + hstep, voffA);
            PG8_WAIT_V(8); PG8_WAIT_L(0); PG8_BAR; PG8_MMA(0, 0, At, B0); PG8_MMA(0, 1, At, B1); PG8_BAR; PG8_SCHED;
            PG8_LDA(At, 1, 1); PG8_STAGE(PG8_SB(1, 0), b3, voffB); PG8_STAGE(PG8_SB(1, 1), b3 + hstep, voffB); PG8_STAGE(PG8_SA(1, 0), a3, voffA);
            PG8_WAIT_V(8); PG8_WAIT_L(0); PG8_BAR; PG8_MMA(1, 0, At, B0); PG8_MMA(1, 1, At, B1); PG8_BAR; PG8_SCHED;
            } else {
            PG8_LDB(B0, 0, 0); PG8_SCHED; PG8_LDA(At, 0, 0); PG8_STAGE(PG8_SA(1, 1), a1 + hstep, voffA);
            PG8_WAIT_L(8); PG8_BAR; PG8_WAIT_L(0); PG8_MMA(0, 0, At, B0); PG8_BAR; PG8_SCHED;
            PG8_LDB(B1, 0, 1); PG8_STAGE(PG8_SB(0, 0), b2, voffB);
            PG8_BAR; PG8_WAIT_L(0); PG8_MMA(0, 1, At, B1); PG8_BAR;
            PG8_LDA(At, 0, 1); PG8_STAGE(PG8_SA(0, 0), a2, voffA);
            PG8_BAR; PG8_WAIT_L(0); PG8_MMA(1, 0, At, B0); PG8_BAR; PG8_SCHED;
            PG8_STAGE(PG8_SB(0, 1), b2 + hstep, voffB);
            PG8_WAIT_V(6); PG8_BAR; PG8_MMA(1, 1, At, B1); PG8_BAR;
            PG8_LDB(B0, 1, 0); PG8_SCHED; PG8_LDA(At, 1, 0); PG8_STAGE(PG8_SA(0, 1), a2 + hstep, voffA);
            PG8_WAIT_L(8); PG8_BAR; PG8_WAIT_L(0); PG8_MMA(0, 0, At, B0); PG8_BAR; PG8_SCHED;
            PG8_LDB(B1, 1, 1); PG8_STAGE(PG8_SB(1, 0), b3, voffB);
            PG8_BAR; PG8_WAIT_L(0); PG8_MMA(0, 1, At, B1); PG8_BAR;
            PG8_LDA(At, 1, 1); PG8_STAGE(PG8_SA(1, 0), a3, voffA);
            PG8_BAR; PG8_WAIT_L(0); PG8_MMA(1, 0, At, B0); PG8_BAR; PG8_SCHED;
            PG8_STAGE(PG8_SB(1, 1), b3 + hstep, voffB);
            PG8_WAIT_V(6); PG8_BAR; PG8_MMA(1, 1, At, B1); PG8_BAR;
            }
        }
        if constexpr (ALIGN_EPI) { if (wr == 0) PG8_BAR; }
        if constexpr (F8) {
            asm volatile("s_nop 15\n\ts_nop 15" : "+v"(acc[0][0][0][0]), "+v"(acc[0][0][0][1]), "+v"(acc[0][0][1][0]), "+v"(acc[0][0][1][1]), "+v"(acc[0][0][2][0]), "+v"(acc[0][0][2][1]), "+v"(acc[0][0][3][0]), "+v"(acc[0][0][3][1]),
                         "+v"(acc[0][1][0][0]), "+v"(acc[0][1][0][1]), "+v"(acc[0][1][1][0]), "+v"(acc[0][1][1][1]), "+v"(acc[0][1][2][0]), "+v"(acc[0][1][2][1]), "+v"(acc[0][1][3][0]), "+v"(acc[0][1][3][1]));
            asm volatile("s_nop 15\n\ts_nop 15" : "+v"(acc[1][0][0][0]), "+v"(acc[1][0][0][1]), "+v"(acc[1][0][1][0]), "+v"(acc[1][0][1][1]), "+v"(acc[1][0][2][0]), "+v"(acc[1][0][2][1]), "+v"(acc[1][0][3][0]), "+v"(acc[1][0][3][1]),
                         "+v"(acc[1][1][0][0]), "+v"(acc[1][1][0][1]), "+v"(acc[1][1][1][0]), "+v"(acc[1][1][1][1]), "+v"(acc[1][1][2][0]), "+v"(acc[1][1][2][1]), "+v"(acc[1][1][3][0]), "+v"(acc[1][1][3][1])); }
        if constexpr (!Epi::AFTER_DRAIN) { E(acc, cur, wr, wc, fr, fq); S.done(cur); }
        if (!has_next) break;
#pragma unroll
        for (int a = 0; a < 2; ++a)
#pragma unroll
            for (int b = 0; b < 2; ++b)
#pragma unroll
                for (int m = 0; m < 4; ++m)
#pragma unroll
                    for (int n = 0; n < 2; ++n) acc[a][b][m][n] = (f32x4){0.f, 0.f, 0.f, 0.f};
        cur = nxt; cA = nA; cB = nB; ++ui; nt = cur.nt ? cur.nt : nt_full;
        if constexpr (ALIGN_EPI) { if (wr == 1) PG8_BAR; }
    }
    PG8_WAIT_V(0);
    if constexpr (!ALIGN_EPI) { if (wr == 0) PG8_BAR; }
    PG8_BAR;
    if constexpr (Epi::AFTER_DRAIN) { E.fused(acc, cur, wr, wc, fr, fq, lds, wid, lane); S.done(cur); }
#undef PG8_SA
#undef PG8_SB
#undef PG8_STAGE
#undef PG8_LDA
#undef PG8_LDB
#undef PG8_MMA
#undef PG8_CAT8
#undef PG8_WAIT_V
#undef PG8_WAIT_L
#undef PG8_BAR
#undef PG8_SCHED
}
}
#define GAS __attribute__((address_space(1)))
#define LAS __attribute__((address_space(3)))
typedef unsigned short bf16;
typedef unsigned v4u __attribute__((ext_vector_type(4)));
typedef float f32x4 __attribute__((ext_vector_type(4)));
typedef short bf16x8 __attribute__((ext_vector_type(8)));
typedef GAS unsigned gu32;
typedef GAS unsigned long long gu64;
#define RLX_AGENT __ATOMIC_RELAXED, __HIP_MEMORY_SCOPE_AGENT
#define LDS_WAIT() asm volatile("s_waitcnt lgkmcnt(0)" ::: "memory")
#define VM_WAIT() asm volatile("s_waitcnt vmcnt(0)" ::: "memory")
__device__ __forceinline__ unsigned long long rt() { return __builtin_amdgcn_s_memrealtime(); }
__device__ __forceinline__ unsigned f2bf(float f) { unsigned u = __builtin_bit_cast(unsigned, f); return (u + 0x7fffu + ((u >> 16) & 1u)) >> 16; }
__device__ __forceinline__ unsigned pk2(float lo, float hi) { return f2bf(lo) | (f2bf(hi) << 16); }

#define XB_TMO      128
#define XB_XCNT(j)  (256  + 64 * (j))
#define XB_XSUB(j)  (1280 + 64 * (j))
#define XB_XGEN(j)  (2304 + 64 * (j))
#define XB_TOP      3328
#define XB_TOPGEN   3392
#define XCD_BAR_WORDS 3456
#define XB_SPIN_CAP (1u << 18)

__device__ __forceinline__ unsigned xb_ld(unsigned* p)              { return __hip_atomic_load(p, __ATOMIC_RELAXED, __HIP_MEMORY_SCOPE_AGENT); }
__device__ __forceinline__ unsigned xb_add(unsigned* p, unsigned v) { return __hip_atomic_fetch_add(p, v, __ATOMIC_RELAXED, __HIP_MEMORY_SCOPE_AGENT); }
__device__ __forceinline__ unsigned xb_xcc_id() { return (unsigned)__builtin_amdgcn_s_getreg((3 << 11) | 20) & 0xFu; }
#define XB_SPIN(cond, bar) do { unsigned _sp = 0; while (cond) { __builtin_amdgcn_s_sleep(1); \
    if ((++_sp & 255u) == 0u) { if (xb_ld(&(bar)[XB_TMO])) break; if (_sp > XB_SPIN_CAP) { atomicAdd(&(bar)[XB_TMO], 1u); break; } } } } while (0)

struct XcdBarrier {
    unsigned* bar; unsigned x;
    volatile LAS unsigned* st;
};

__device__ __forceinline__ XcdBarrier xcd_barrier_post(unsigned* bar, volatile LAS unsigned* st) {
    XcdBarrier b; b.bar = bar; b.x = xb_xcc_id(); b.st = st;
    if (threadIdx.x == 0) (void)xb_add(&bar[XB_XCNT(b.x)], 1u);
    return b;
}
__device__ __forceinline__ void xcd_barrier_complete(unsigned* bar, unsigned x, unsigned& nloc, unsigned& nx) {
    const unsigned G = gridDim.x * gridDim.y * gridDim.z;
    unsigned sum, cnt, mine, sp = 0u;
    for (;;) {
        sum = 0u; cnt = 0u; mine = 0u;
#pragma unroll
        for (unsigned j = 0; j < 16; ++j) { const unsigned c = xb_ld(&bar[XB_XCNT(j)]); sum += c; cnt += (c > 0u) ? 1u : 0u; mine = (j == x) ? c : mine; }
        if (sum == G) break;
        __builtin_amdgcn_s_sleep(1);
        if ((++sp & 255u) == 0u) { if (xb_ld(&bar[XB_TMO])) break; if (sp > XB_SPIN_CAP) { atomicAdd(&bar[XB_TMO], 1u); break; } }
    }
    nloc = mine > 0u ? mine : 1u; nx = cnt > 0u ? cnt : 1u;
}

__device__ __forceinline__ void xcd_barrier(const XcdBarrier& b) {
    asm volatile("s_waitcnt vmcnt(0)" ::: "memory");
    __syncthreads();
    if (threadIdx.x == 0) {
        unsigned* bar = b.bar;
        __builtin_amdgcn_s_waitcnt(0);
        unsigned nloc = b.st[0], nx = b.st[1];
        if (nloc == 0u) { xcd_barrier_complete(bar, b.x, nloc, nx); b.st[0] = nloc; b.st[1] = nx; }
        const unsigned old = xb_add(&bar[XB_XSUB(b.x)], 1u);
        const unsigned gen = old / nloc;
        if (old + 1u == (gen + 1u) * nloc) {
            __builtin_amdgcn_fence(__ATOMIC_RELEASE, "agent");
            asm volatile("s_waitcnt vmcnt(0)" ::: "memory");
            const unsigned og = xb_add(&bar[XB_TOP], 1u);
            const unsigned tg = og / nx;
            if (og + 1u == (tg + 1u) * nx) xb_add(&bar[XB_TOPGEN], 1u);
            else XB_SPIN(xb_ld(&bar[XB_TOPGEN]) == tg, bar);
            __builtin_amdgcn_fence(__ATOMIC_ACQUIRE, "agent");
            xb_add(&bar[XB_XGEN(b.x)], 1u);
            asm volatile("s_waitcnt vmcnt(0)" ::: "memory");
        } else {
            XB_SPIN(xb_ld(&bar[XB_XGEN(b.x)]) == gen, bar);
            __builtin_amdgcn_fence(__ATOMIC_ACQUIRE, "agent");
            asm volatile("s_waitcnt vmcnt(0)" ::: "memory");
        }
    }
    __syncthreads();
}

constexpr int NWAVES = 8;
constexpr int DM = 2048, MCTX = 4096, MLAT = 8192, MTOK = MCTX + MLAT, DFF = 5632, INW = 5120, WA = 1024, NADA = 9 * DM;
constexpr float EPS = 1e-6f;
constexpr float LOG2E_F = 1.4426950408889634f;
constexpr int KSPLIT_ADA = 16, ADA_ROWS = DM / KSPLIT_ADA;
#ifndef MIX_FP8
#define MIX_FP8 1
#endif
#ifndef FFN_FP8
#define FFN_FP8 1
#endif
constexpr int NSET = 5;

constexpr size_t MiB = 1u << 20;
constexpr size_t WS_CTL = 0, CTL_ZERO_BYTES = 1 * MiB;
constexpr size_t WS_MODP = 1 * MiB;
constexpr size_t WS_MOD = 7 * MiB;
constexpr size_t WS_WSB = 7 * MiB + 512 * 1024;
constexpr size_t WS_CK = 8 * MiB, WS_CV = 12 * MiB;
constexpr size_t WS_WGU1 = 16 * MiB, WS_WD1 = 60 * MiB, WS_WIN = 82 * MiB, WS_WOUT = 102 * MiB, WS_WGU2 = 110 * MiB, WS_WD2 = 154 * MiB;
constexpr size_t WS_H = 176 * MiB;
constexpr size_t WS_ACT = 224 * MiB;
constexpr size_t WS_Q = 356 * MiB, WS_K = 380 * MiB, WS_V = 404 * MiB, WS_U = 428 * MiB, WS_VG = 452 * MiB;
constexpr size_t WS_MIX = 476 * MiB;
constexpr size_t WS_END = 524 * MiB;
constexpr int CW_BAR = 4096;

constexpr int RING_OFF = 0, RING_BYTES = 131072;
constexpr int LDSCTL_OFF = RING_BYTES, MISC_OFF = LDSCTL_OFF + 320;
constexpr int LDS_BYTES = 147456;

struct Frame {
    LAS unsigned char* lds;
    volatile LAS unsigned* MISC;
    gu32* ctl;
    int tid, lane, wave;
    int vcu, G;
};

__device__ __forceinline__ float wave_sum(float v) {
#pragma unroll
    for (int o = 1; o < 64; o <<= 1) v += __shfl_xor(v, o);
    return v;
}
__device__ __forceinline__ float bf2f(unsigned short b) { return __builtin_bit_cast(float, (unsigned)b << 16); }
__device__ __forceinline__ float bflo(unsigned w) { return __builtin_bit_cast(float, w << 16); }
__device__ __forceinline__ float bfhi(unsigned w) { return __builtin_bit_cast(float, w & 0xffff0000u); }

template <bool F8> __device__ __forceinline__ void p0_transpose_item(const float* W, int K, int N, bf16* WT, int mode, LAS float* scr, int item, int lane) {
    const int nblk = N / 32, kb = item / nblk, nb = item % nblk, k0 = 64 * kb, n0 = 32 * nb;
    const int drow0 = mode == 0 ? n0 : ((n0 >> 7) * 256 + (mode == 2 ? 128 : 0) + (n0 & 127));
#pragma unroll 8
    for (int i = 0; i < 32; ++i) { const int kk = 2 * i + (lane >> 5); scr[kk * 33 + (lane & 31)] = __builtin_nontemporal_load(W + (size_t)(k0 + kk) * N + n0 + (lane & 31)); }
    LDS_WAIT(); asm volatile("" ::: "memory");
    const int c = lane & 7;
#pragma unroll
    for (int j = 0; j < 4; ++j) { const int n = (lane >> 3) + 8 * j; const LAS float* s = scr + (8 * c) * 33 + n;
        if constexpr (F8) { pg8::u32x2 o; o.x = pg8::pack4_fp8(s[0 * 33] * pg8::F8_SW, s[1 * 33] * pg8::F8_SW, s[2 * 33] * pg8::F8_SW, s[3 * 33] * pg8::F8_SW);
            o.y = pg8::pack4_fp8(s[4 * 33] * pg8::F8_SW, s[5 * 33] * pg8::F8_SW, s[6 * 33] * pg8::F8_SW, s[7 * 33] * pg8::F8_SW);
            *(GAS pg8::u32x2*)((unsigned char*)WT + (size_t)(drow0 + n) * K + k0 + 8 * c) = o; }
        else { v4u o; o.x = pk2(s[0 * 33], s[1 * 33]); o.y = pk2(s[2 * 33], s[3 * 33]); o.z = pk2(s[4 * 33], s[5 * 33]); o.w = pk2(s[6 * 33], s[7 * 33]);
            *(GAS v4u*)(WT + (size_t)(drow0 + n) * K + k0 + 8 * c) = o; } }
    LDS_WAIT(); asm volatile("" ::: "memory");
}
__device__ __forceinline__ void p0_ada_item(const float* c_lat, const float* c_ctx, const float* w_ada, float* part, LAS float* scr, int item, int lane) {
    const int cc = item % 72, ks = item / 72, k0 = ks * ADA_ROWS;
    for (int idx = lane; idx < NSET * ADA_ROWS; idx += 64) { const int j = idx / ADA_ROWS, kk = idx % ADA_ROWS;
        const float cv = j == 0 ? c_ctx[k0 + kk] : c_lat[(size_t)(j - 1) * DM + k0 + kk];
        scr[idx] = cv / (1.0f + __expf(-cv)); }
    LDS_WAIT(); asm volatile("" ::: "memory");
    f32x4 acc[NSET];
#pragma unroll
    for (int j = 0; j < NSET; ++j) acc[j] = (f32x4){0.f, 0.f, 0.f, 0.f};
    const float* wp = w_ada + (size_t)k0 * NADA + cc * 256 + lane * 4;
#pragma unroll 2
    for (int k4 = 0; k4 < ADA_ROWS; k4 += 4) {
        f32x4 w[4];
#pragma unroll
        for (int i = 0; i < 4; ++i) w[i] = __builtin_nontemporal_load((const f32x4*)(wp + (size_t)(k4 + i) * NADA));
#pragma unroll
        for (int j = 0; j < NSET; ++j) { const f32x4 s = *(const LAS f32x4*)(scr + j * ADA_ROWS + k4);
            acc[j] += w[0] * s[0]; acc[j] += w[1] * s[1]; acc[j] += w[2] * s[2]; acc[j] += w[3] * s[3]; }
    }
#pragma unroll
    for (int j = 0; j < NSET; ++j) *(f32x4*)(part + ((size_t)(ks * NSET + j)) * NADA + cc * 256 + lane * 4) = acc[j];
    LDS_WAIT(); asm volatile("" ::: "memory");
}

template <bool F8> __device__ __forceinline__ void rownorm_mod_row(float* xrow, const float* prow, const float* A, const float* B, bf16* orow, int lane) {
    GAS f32x4* xr = (GAS f32x4*)xrow + lane;
    f32x4 v[8]; float s = 0.f;
#pragma unroll
    for (int j = 0; j < 8; ++j) v[j] = xr[64 * j];
    if (prow) {
#pragma unroll
        for (int j = 0; j < 8; ++j) { v[j] += *((const GAS f32x4*)prow + lane + 64 * j); xr[64 * j] = v[j]; } }
#pragma unroll
    for (int j = 0; j < 8; ++j) s += (v[j].x * v[j].x + v[j].y * v[j].y) + (v[j].z * v[j].z + v[j].w * v[j].w);
    const float rstd = 1.0f / sqrtf(wave_sum(s) * (1.0f / DM) + EPS);
    GAS unsigned long long* o8 = (GAS unsigned long long*)orow + lane;
#pragma unroll
    for (int j = 0; j < 8; ++j) { const f32x4 a = *((const f32x4*)A + lane + 64 * j), b = *((const f32x4*)B + lane + 64 * j);
        const f32x4 y = v[j] * rstd * a + b;
        if constexpr (F8) ((GAS unsigned*)orow)[lane + 64 * j] = pg8::pack4_fp8(y.x * pg8::F8_SA, y.y * pg8::F8_SA, y.z * pg8::F8_SA, y.w * pg8::F8_SA);
        else o8[64 * j] = (unsigned long long)pg8::cvt_pk_bf16(y.x, y.y) | ((unsigned long long)pg8::cvt_pk_bf16(y.z, y.w) << 32); }
}

typedef float f32x16 __attribute__((ext_vector_type(16)));
typedef short s16x4 __attribute__((ext_vector_type(4)));
__device__ __forceinline__ int crow(int r, int hi) { return (r & 3) + 8 * (r >> 2) + 4 * hi; }
__device__ __forceinline__ s16x4 vtr(const LAS unsigned char* p) { return __builtin_bit_cast(s16x4, __builtin_amdgcn_ds_read_tr16_b64_v4i16((LAS s16x4*)p)); }
constexpr int AT_K = 0, AT_V = 16384, AT_WS = 32768, AT_TB = 32768 + 2048 + 256, AT_END = AT_TB + 2048 + 512;
struct AttnArgs { const bf16* qb; const bf16* kb; const bf16* vb; const bf16* ckb; const bf16* cvb; bf16* mixb; const float* rpb; };

__device__ __forceinline__ void attn_unit(LAS unsigned char* lds, const AttnArgs& T, bool lat, int b, int h, int rb) {
    const int tid = threadIdx.x, lane = tid & 63, r32 = lane & 31, hi = lane >> 5; const int wid = __builtin_amdgcn_readfirstlane(tid >> 6);
    int nA, nB, gr0 = 0, rq = 0, c0 = 0, rs = 0; const bf16 *KA, *VA; size_t rowA, rowB = 0, qrow;
    if (lat) { rq = 4 * rb + (wid >> 1); c0 = (wid & 1) * 32; rs = min(max(rq - 4, 0), 24);
        const int rs_min = min(max(4 * rb - 4, 0), 24), rs_max = min(max(4 * rb - 1, 0), 24); nB = rs_max + 8 - rs_min; gr0 = rs_min;
        nA = 8; KA = T.ckb; VA = T.cvb; rowA = (size_t)b * 512; rowB = (size_t)MCTX + (size_t)b * 2048 + 64 * rs_min; qrow = (size_t)MCTX + (size_t)b * 2048 + rq * 64 + c0; }
    else { nA = 4; nB = 0; KA = T.kb; VA = T.vb; rowA = (size_t)b * 256; qrow = (size_t)b * 256 + wid * 32; }
    const int NT = nA + nB;
    __syncthreads();
    if (lat && tid < 480) { const int e = tid & 31, dri = tid >> 5; ((LAS float*)(lds + AT_TB))[tid] = e < 31 ? T.rpb[h * 465 + dri * 31 + e] * LOG2E_F : 0.f; }
    bf16x8 qr[4];
#pragma unroll
    for (int d0 = 0; d0 < 4; ++d0) qr[d0] = *(const bf16x8*)(T.qb + (qrow + r32) * WA + h * 64 + d0 * 16 + hi * 8);
    LAS float* wsf = (LAS float*)(lds + AT_WS) + wid * 64;
    f32x16 o[2]; o[0] = (f32x16){}; o[1] = (f32x16){};
    float m_run = -INFINITY, l_run = 0.f;
    v4u kreg, vreg;
#define AT_LOAD(t) do { const bf16* Kp_; const bf16* Vp_; size_t row_; if ((t) < nA) { Kp_ = KA; Vp_ = VA; row_ = rowA + 64 * (size_t)(t); } else { Kp_ = T.kb; Vp_ = T.vb; row_ = rowB + 64 * (size_t)((t) - nA); } \
        kreg = *(const v4u*)(Kp_ + (row_ + skey) * WA + h * 64 + sch * 8); \
        vreg = *(const v4u*)(Vp_ + (row_ + skey) * WA + h * 64 + sch * 8); } while (0)
    const int skey = tid >> 3, sch = tid & 7;
    const int kst = skey * 128 + ((sch ^ ((skey >> 1) & 7)) * 16), vst = (sch >> 2) * 4096 + skey * 64 + (sch & 3) * 16;
    const int qc = c0 + r32, qcs = min(max(qc - 8, 0), 48), bbase = 4 * hi - qc + 15;
    unsigned vmask = 0u;
#pragma unroll
    for (int r = 0; r < 16; ++r) { const int kc = crow(r, hi); vmask |= (kc >= qcs && kc < qcs + 16) ? (1u << r) : 0u; vmask |= (kc + 32 >= qcs && kc + 32 < qcs + 16) ? (1u << (16 + r)) : 0u; }
    const int ksw = (r32 >> 1) & 7;
    AT_LOAD(0);
    for (int t = 0; t < NT; ++t) {
        const int slot = (t & 1) * 8192;
        *(LAS v4u*)(lds + AT_K + slot + kst) = kreg;
        *(LAS v4u*)(lds + AT_V + slot + vst) = vreg;
        __syncthreads();
        if (t + 1 < NT) AT_LOAD(t + 1);
        const bool local = t >= nA; const int gr = gr0 + (t - nA);
        if (local && (gr < rs || gr >= rs + 8)) continue;
        f32x16 p0, p1;
        if (local) {
            const LAS float* tb = (const LAS float*)(lds + AT_TB) + (gr - rq + 7) * 32 + bbase;
#pragma unroll
            for (int r = 0; r < 16; ++r) { const int cr0 = (r & 3) + 8 * (r >> 2);
                const float b0 = tb[cr0], b1 = tb[cr0 + 32];
                p0[r] = ((vmask >> r) & 1u) ? b0 : -1e30f; p1[r] = ((vmask >> (16 + r)) & 1u) ? b1 : -1e30f; }
        } else { p0 = (f32x16){}; p1 = (f32x16){}; }
        const LAS unsigned char* kbp = lds + AT_K + slot + r32 * 128;
#pragma unroll
        for (int d0 = 0; d0 < 4; ++d0) { const int co = ((2 * d0 + hi) ^ ksw) * 16; const bf16x8 k0 = *(const LAS bf16x8*)(kbp + co), k1 = *(const LAS bf16x8*)(kbp + co + 4096);
            p0 = __builtin_amdgcn_mfma_f32_32x32x16_bf16(k0, qr[d0], p0, 0, 0, 0); p1 = __builtin_amdgcn_mfma_f32_32x32x16_bf16(k1, qr[d0], p1, 0, 0, 0); }
        float mx = fmaxf(p0[0], p1[0]);
#pragma unroll
        for (int r = 1; r < 16; ++r) mx = fmaxf(mx, fmaxf(p0[r], p1[r]));
        mx = fmaxf(mx, __shfl_xor(mx, 32));
        const float m_new = fmaxf(m_run, mx);
        if (__any(m_new > m_run)) {
            const float alpha = __builtin_amdgcn_exp2f(m_run - m_new);
            l_run *= alpha; m_run = m_new;
            if (hi == 0) wsf[r32] = alpha;
            LDS_WAIT(); asm volatile("" ::: "memory");
#pragma unroll
            for (int g = 0; g < 4; ++g) { const f32x4 af = *(const LAS f32x4*)(wsf + 8 * g + 4 * hi);
#pragma unroll
                for (int i = 0; i < 4; ++i) { o[0][4 * g + i] *= af[i]; o[1][4 * g + i] *= af[i]; } }
        }
        float ls = 0.f;
#pragma unroll
        for (int r = 0; r < 16; ++r) { p0[r] = __builtin_amdgcn_exp2f(p0[r] - m_run); p1[r] = __builtin_amdgcn_exp2f(p1[r] - m_run); ls += p0[r] + p1[r]; }
        l_run += ls;
        v4u pw[4];
#pragma unroll
        for (int s = 0; s < 2; ++s) {
            pw[s] = (v4u){pg8::cvt_pk_bf16(p0[8 * s], p0[8 * s + 1]), pg8::cvt_pk_bf16(p0[8 * s + 2], p0[8 * s + 3]), pg8::cvt_pk_bf16(p0[8 * s + 4], p0[8 * s + 5]), pg8::cvt_pk_bf16(p0[8 * s + 6], p0[8 * s + 7])};
            pw[2 + s] = (v4u){pg8::cvt_pk_bf16(p1[8 * s], p1[8 * s + 1]), pg8::cvt_pk_bf16(p1[8 * s + 2], p1[8 * s + 3]), pg8::cvt_pk_bf16(p1[8 * s + 4], p1[8 * s + 5]), pg8::cvt_pk_bf16(p1[8 * s + 6], p1[8 * s + 7])}; }
        const LAS unsigned char* vbp = lds + AT_V + slot + ((lane >> 4) & 1) * 32 + (lane & 3) * 8 + (4 * hi + ((lane & 15) >> 2)) * 64;
#pragma unroll
        for (int d0 = 0; d0 < 2; ++d0)
#pragma unroll
            for (int ks = 0; ks < 4; ++ks) { const s16x4 lo = vtr(vbp + d0 * 4096 + ks * 1024), hh = vtr(vbp + d0 * 4096 + ks * 1024 + 512);
                const bf16x8 vf = (bf16x8){lo[0], lo[1], lo[2], lo[3], hh[0], hh[1], hh[2], hh[3]};
                o[d0] = __builtin_amdgcn_mfma_f32_32x32x16_bf16(__builtin_bit_cast(bf16x8, pw[ks]), vf, o[d0], 0, 0, 0); }
    }
#undef AT_LOAD
    l_run += __shfl_xor(l_run, 32);
    if (hi == 0) wsf[r32] = 1.0f / l_run;
    LDS_WAIT(); asm volatile("" ::: "memory");
    bf16* Ow = T.mixb + qrow * DM + h * 64 + r32;
#pragma unroll
    for (int g = 0; g < 4; ++g) { const f32x4 af = *(const LAS f32x4*)(wsf + 8 * g + 4 * hi);
#pragma unroll
        for (int i = 0; i < 4; ++i) { const int q = 8 * g + 4 * hi + i;
            Ow[(size_t)q * DM] = (bf16)f2bf(o[0][4 * g + i] * af[i]); Ow[(size_t)q * DM + 32] = (bf16)f2bf(o[1][4 * g + i] * af[i]); } }
}

struct GateArgs { const bf16* ub; const bf16* vgb; const bf16* wsb; const float* b_s; const float* gnorm; bf16* mixb; };
__device__ __forceinline__ void gate_units(LAS unsigned char* lds, const GateArgs& T, int u0, int ustride, int nunits) {
    const int tid = threadIdx.x, lane = tid & 63, r32 = lane & 31, hi = lane >> 5; const int wid = __builtin_amdgcn_readfirstlane(tid >> 6);
    if (u0 >= nunits) return;
    const int ch = tid & 15, rowb = tid >> 4;
    v4u raw[4];
#define GT_LOADVG(u) do { const size_t r0_ = (size_t)((u) >> 3) * 128; const int g_ = (u) & 7; _Pragma("unroll") for (int i = 0; i < 4; ++i) raw[i] = *(const v4u*)(T.vgb + (r0_ + rowb + 32 * i) * WA + g_ * 128 + ch * 8); } while (0)
    GT_LOADVG(u0);
    __syncthreads();
    LAS float* S = (LAS float*)(lds + 32768);
    for (int u = u0; u < nunits; u += ustride) {
        const int n = u >> 3, g = u & 7; const size_t row0 = (size_t)n * 128;
        const f32x4 g0 = *(const f32x4*)(T.gnorm + g * 128 + ch * 8), g1 = *(const f32x4*)(T.gnorm + g * 128 + ch * 8 + 4);
#pragma unroll
        for (int i = 0; i < 4; ++i) { const int row = rowb + 32 * i;
            float v[8]; v[0] = bflo(raw[i].x); v[1] = bfhi(raw[i].x); v[2] = bflo(raw[i].y); v[3] = bfhi(raw[i].y); v[4] = bflo(raw[i].z); v[5] = bfhi(raw[i].z); v[6] = bflo(raw[i].w); v[7] = bfhi(raw[i].w);
            float ss = 0.f;
#pragma unroll
            for (int e = 0; e < 8; ++e) ss += v[e] * v[e];
            ss += __shfl_xor(ss, 1); ss += __shfl_xor(ss, 2); ss += __shfl_xor(ss, 4); ss += __shfl_xor(ss, 8);
            const float rstd = 1.0f / sqrtf(ss * (1.0f / 128.0f) + EPS);
            v4u w; w.x = pg8::cvt_pk_bf16(v[0] * rstd * g0[0], v[1] * rstd * g0[1]); w.y = pg8::cvt_pk_bf16(v[2] * rstd * g0[2], v[3] * rstd * g0[3]);
            w.z = pg8::cvt_pk_bf16(v[4] * rstd * g1[0], v[5] * rstd * g1[1]); w.w = pg8::cvt_pk_bf16(v[6] * rstd * g1[2], v[7] * rstd * g1[3]);
            *(LAS v4u*)(lds + (ch >> 2) * 8192 + row * 64 + (ch & 3) * 16) = w; }
        __syncthreads();
        if (u + ustride < nunits) GT_LOADVG(u + ustride);
        v4u ureg[4];
#pragma unroll
        for (int i = 0; i < 4; ++i) ureg[i] = *(const v4u*)(T.ub + (row0 + rowb + 32 * i) * WA + g * 128 + ch * 8);
        const int ib = wid >> 1, cb0 = 2 * (wid & 1);
        f32x16 acc[2]; acc[0] = (f32x16){}; acc[1] = (f32x16){};
        const bf16* wfrag = T.wsb + ((size_t)(g * 128 + 32 * ib + r32) * 16 + hi) * 8;
        const LAS unsigned char* vbp = lds + ((lane >> 4) & 1) * 32 + (lane & 3) * 8 + (4 * hi + ((lane & 15) >> 2)) * 64;
        bf16x8 af[8];
#pragma unroll
        for (int ks = 0; ks < 8; ++ks) af[ks] = *(const bf16x8*)(wfrag + ks * 16);
#pragma unroll
        for (int ks = 0; ks < 8; ++ks) {
#pragma unroll
            for (int cbi = 0; cbi < 2; ++cbi) { const LAS unsigned char* q = vbp + (cb0 + cbi) * 8192 + ks * 1024;
                const s16x4 lo = vtr(q), hh = vtr(q + 512);
                const bf16x8 vf = (bf16x8){lo[0], lo[1], lo[2], lo[3], hh[0], hh[1], hh[2], hh[3]};
                acc[cbi] = __builtin_amdgcn_mfma_f32_32x32x16_bf16(af[ks], vf, acc[cbi], 0, 0, 0); }
        }
#pragma unroll
        for (int q4 = 0; q4 < 4; ++q4) { const f32x4 bs = *(const f32x4*)(T.b_s + g * 128 + 32 * ib + 8 * q4 + 4 * hi);
#pragma unroll
            for (int e = 0; e < 4; ++e) { const int il = 32 * ib + 8 * q4 + 4 * hi + e;
                S[il * 128 + 32 * cb0 + r32] = acc[0][4 * q4 + e] + bs[e]; S[il * 128 + 32 * (cb0 + 1) + r32] = acc[1][4 * q4 + e] + bs[e]; } }
        __syncthreads();
#pragma unroll
        for (int i = 0; i < 4; ++i) { const int row = rowb + 32 * i;
            const f32x4 s0 = *(const LAS f32x4*)(S + row * 128 + ch * 8), s1 = *(const LAS f32x4*)(S + row * 128 + ch * 8 + 4);
            v4u w; w.x = pg8::cvt_pk_bf16(bflo(ureg[i].x) * s0[0], bfhi(ureg[i].x) * s0[1]); w.y = pg8::cvt_pk_bf16(bflo(ureg[i].y) * s0[2], bfhi(ureg[i].y) * s0[3]);
            w.z = pg8::cvt_pk_bf16(bflo(ureg[i].z) * s1[0], bfhi(ureg[i].z) * s1[1]); w.w = pg8::cvt_pk_bf16(bflo(ureg[i].w) * s1[2], bfhi(ureg[i].w) * s1[3]);
            *(v4u*)(T.mixb + (row0 + row) * DM + WA + g * 128 + ch * 8) = w; }
    }
#undef GT_LOADVG
}


#ifndef SELFCHECK
#define SELFCHECK 0
#endif
#if SELFCHECK
__device__ __forceinline__ void selfcheck_mixer(LAS unsigned char* lds, int gw, int lane, int wave, const bf16* QB, const bf16* KB, const bf16* VB, const bf16* CKB, const bf16* CVB,
                                                const bf16* UB, const bf16* VGB, const bf16* MIXB, const float* rpb, const float* w_s, const float* b_s, const float* gnorm, unsigned* errw) {
    LAS float* P = (LAS float*)(lds + wave * 4096);
    {
        const int b = gw & 3, h = (gw >> 2) & 15, sel = gw >> 9;
        int n = (gw * 211) & 2047;
        if (sel == 1) n = (gw & 63) + 64 * ((gw >> 6) & 7); else if (sel == 2) n = 2047 - ((gw & 63) + 64 * ((gw >> 6) & 7)); else if (sel == 3) n = (gw * 977 + 5) & 2047;
        const int r = n >> 6, c = n & 63, rs = min(max(r - 4, 0), 24), cs = min(max(c - 8, 0), 48);
        const size_t qrow = (size_t)MCTX + (size_t)b * 2048 + n;
        float mx = -3.0e38f;
        for (int kidx = lane; kidx < 640; kidx += 64) {
            const bf16* kp; float bias = 0.f;
            if (kidx < 128) { const int krow = rs + (kidx >> 4), kcol = cs + (kidx & 15); kp = KB + ((size_t)MCTX + (size_t)b * 2048 + krow * 64 + kcol) * WA + h * 64;
                bias = rpb[h * 465 + (krow - r + 7) * 31 + (kcol - c + 15)] * LOG2E_F; }
            else kp = CKB + ((size_t)b * 512 + (kidx - 128)) * WA + h * 64;
            float d = 0.f;
            for (int e = 0; e < 64; ++e) d += bf2f(QB[qrow * WA + h * 64 + e]) * bf2f(kp[e]);
            d += bias; P[kidx] = d; mx = fmaxf(mx, d); }
#pragma unroll
        for (int o = 1; o < 64; o <<= 1) mx = fmaxf(mx, __shfl_xor(mx, o));
        LDS_WAIT(); asm volatile("" ::: "memory");
        float sum = 0.f;
        for (int kidx = lane; kidx < 640; kidx += 64) { const float e = exp2f(P[kidx] - mx); P[kidx] = e; sum += e; }
        sum = wave_sum(sum);
        LDS_WAIT(); asm volatile("" ::: "memory");
        float o = 0.f;
        for (int kidx = 0; kidx < 640; ++kidx) { const bf16* vp;
            if (kidx < 128) { const int krow = rs + (kidx >> 4), kcol = cs + (kidx & 15); vp = VB + ((size_t)MCTX + (size_t)b * 2048 + krow * 64 + kcol) * WA + h * 64; }
            else vp = CVB + ((size_t)b * 512 + (kidx - 128)) * WA + h * 64;
            o += P[kidx] * bf2f(vp[lane]); }
        o /= sum;
        const float fast = bf2f(MIXB[qrow * DM + h * 64 + lane]);
        float err = fabsf(fast - o), rms = wave_sum(o * o);
#pragma unroll
        for (int s = 1; s < 64; s <<= 1) err = fmaxf(err, __shfl_xor(err, s));
        const float rel = err / (sqrtf(rms * (1.0f / 64.0f)) + 1e-6f);
        if (lane == 0) atomicMax(errw + 0, __float_as_uint(rel));
        LDS_WAIT(); asm volatile("" ::: "memory");
    }
    {
        const int b = gw & 15, h = (gw >> 4) & 15, s = (gw * 37 + (gw >> 8)) & 255;
        const size_t qrow = (size_t)b * 256 + s;
        float mx = -3.0e38f;
        for (int kidx = lane; kidx < 256; kidx += 64) { const bf16* kp = KB + ((size_t)b * 256 + kidx) * WA + h * 64;
            float d = 0.f;
            for (int e = 0; e < 64; ++e) d += bf2f(QB[qrow * WA + h * 64 + e]) * bf2f(kp[e]);
            P[kidx] = d; mx = fmaxf(mx, d); }
#pragma unroll
        for (int o = 1; o < 64; o <<= 1) mx = fmaxf(mx, __shfl_xor(mx, o));
        LDS_WAIT(); asm volatile("" ::: "memory");
        float sum = 0.f;
        for (int kidx = lane; kidx < 256; kidx += 64) { const float e = exp2f(P[kidx] - mx); P[kidx] = e; sum += e; }
        sum = wave_sum(sum);
        LDS_WAIT(); asm volatile("" ::: "memory");
        float o = 0.f;
        for (int kidx = 0; kidx < 256; ++kidx) o += P[kidx] * bf2f(VB[((size_t)b * 256 + kidx) * WA + h * 64 + lane]);
        o /= sum;
        const float fast = bf2f(MIXB[qrow * DM + h * 64 + lane]);
        float err = fabsf(fast - o), rms = wave_sum(o * o);
#pragma unroll
        for (int s2 = 1; s2 < 64; s2 <<= 1) err = fmaxf(err, __shfl_xor(err, s2));
        const float rel = err / (sqrtf(rms * (1.0f / 64.0f)) + 1e-6f);
        if (lane == 0) atomicMax(errw + 1, __float_as_uint(rel));
        LDS_WAIT(); asm volatile("" ::: "memory");
    }
    {
        const int row = (gw * 6 + (gw >> 5)) % MTOK, c = (gw * 509 + 3) & 1023, g = c >> 7, i = row & 127; const size_t chunk0 = (size_t)(row & ~127);
        float contrib = 0.f;
        for (int j = lane; j < 128; j += 64) { float ss = 0.f;
            for (int e = 0; e < 128; ++e) { const float v = bf2f(VGB[(chunk0 + j) * WA + g * 128 + e]); ss += v * v; }
            const float rstd = 1.0f / sqrtf(ss * (1.0f / 128.0f) + EPS);
            contrib += w_s[((size_t)g * 128 + i) * 128 + j] * (bf2f(VGB[(chunk0 + j) * WA + c]) * rstd * gnorm[c]); }
        const float s = wave_sum(contrib) + b_s[g * 128 + i];
        const float gm = bf2f(UB[(size_t)row * WA + c]) * s, fast = bf2f(MIXB[(size_t)row * DM + WA + c]);
        const float rel = fabsf(fast - gm) / (fabsf(gm) + 0.1f);
        if (lane == 0) atomicMax(errw + 2, __float_as_uint(rel));
    }
}
#endif

struct Args { const float* in[26]; float* out; unsigned char* ws; int ph_lo, ph_hi, li, pad; };
constexpr int N_PHASES = 14;
__global__ void __launch_bounds__(NWAVES * 64, 2) mega_fwd(Args args) {
    extern __shared__ __attribute__((aligned(16))) unsigned char lds[];
    Frame F;
    F.lds = (LAS unsigned char*)lds;
    F.MISC = (volatile LAS unsigned*)(F.lds + MISC_OFF);
    F.tid = threadIdx.x; F.lane = F.tid & 63; F.wave = __builtin_amdgcn_readfirstlane(F.tid >> 6);
    F.G = gridDim.x; { const int bx = blockIdx.x; F.vcu = (F.G % 8 == 0) ? (bx % 8) * (F.G / 8) + bx / 8 : bx; }
    unsigned char* ws = args.ws;
    F.ctl = (gu32*)(ws + WS_CTL);
    const float* x_prompt = args.in[0]; const float* x_sample = args.in[1];
    float* const xbuf = args.out;
    float* const state_k = args.out + (size_t)MTOK * DM; float* const state_v = state_k + (size_t)MCTX * WA;
    bf16* const Wgu1 = (bf16*)(ws + WS_WGU1); bf16* const Wd1 = (bf16*)(ws + WS_WD1); bf16* const Win = (bf16*)(ws + WS_WIN); bf16* const Wout = (bf16*)(ws + WS_WOUT);
    bf16* const Wgu2 = (bf16*)(ws + WS_WGU2); bf16* const Wd2 = (bf16*)(ws + WS_WD2);
    bf16* const HB = (bf16*)(ws + WS_H); bf16* const ACT = (bf16*)(ws + WS_ACT);
    bf16* const QB = (bf16*)(ws + WS_Q); bf16* const KB = (bf16*)(ws + WS_K); bf16* const VB = (bf16*)(ws + WS_V); bf16* const UB = (bf16*)(ws + WS_U); bf16* const VGB = (bf16*)(ws + WS_VG);
    bf16* const MIXB = (bf16*)(ws + WS_MIX); bf16* const CKB = (bf16*)(ws + WS_CK); bf16* const CVB = (bf16*)(ws + WS_CV);
    float* const MODP = (float*)(ws + WS_MODP); float* const MOD = (float*)(ws + WS_MOD);
    bf16* const WSB = (bf16*)(ws + WS_WSB);
    float* const PBUF = (float*)(ws + WS_Q);
    const bool split = (F.G == 256);

    for (int u = F.tid; u < (LDS_BYTES - LDSCTL_OFF) / 4; u += NWAVES * 64) ((LAS unsigned*)(F.lds + LDSCTL_OFF))[u] = 0u;
    __syncthreads();
    XcdBarrier bar = xcd_barrier_post((unsigned*)(F.ctl + CW_BAR) + args.li * XCD_BAR_WORDS, F.MISC + 8);
    const int lo = args.ph_lo, hi = args.ph_hi;
#define IN(k) (lo <= (k) && (k) < hi)
#ifndef PROBE_REPEAT
#define PROBE_REPEAT -1
#endif
#define REP(k) for (int rep_ = 0; rep_ < ((PROBE_REPEAT == (k)) ? 2 : 1); ++rep_)
#define REPBAR() do { if (rep_) xcd_barrier(bar); } while (0)
#define SEAM(k) do { if (IN(k) && IN((k) + 1)) xcd_barrier(bar); } while (0)
    const int gw = F.vcu * NWAVES + F.wave, NGW = F.G * NWAVES;

    if (IN(0)) REP(0) { REPBAR();
        LAS float* scr = (LAS float*)(F.lds + RING_OFF + F.wave * 16384);
        { const int gt = F.vcu * (NWAVES * 64) + F.tid, NGT = F.G * NWAVES * 64;
          for (int i = gt; i < 2 * 262144; i += NGT) { const int which = i >= 262144, e = (which ? i - 262144 : i) * 8; const float* src = args.in[2 + which] + e;
              const f32x4 a = *(const f32x4*)src, b2 = *(const f32x4*)(src + 4);
              v4u o; o.x = pg8::cvt_pk_bf16(a[0], a[1]); o.y = pg8::cvt_pk_bf16(a[2], a[3]); o.z = pg8::cvt_pk_bf16(b2[0], b2[1]); o.w = pg8::cvt_pk_bf16(b2[2], b2[3]);
              *(v4u*)((which ? CVB : CKB) + e) = o; } }
        { const int gt = F.vcu * (NWAVES * 64) + F.tid, NGT = F.G * NWAVES * 64;
          for (int i = gt; i < 16384; i += NGT) { const int hh = i & 1, ks = (i >> 1) & 7, gi = i >> 4; const float* src = args.in[16] + (size_t)gi * 128 + 16 * ks + 4 * hh;
              const f32x4 a = *(const f32x4*)src, b2 = *(const f32x4*)(src + 8);
              v4u o; o.x = pg8::cvt_pk_bf16(a[0], a[1]); o.y = pg8::cvt_pk_bf16(a[2], a[3]); o.z = pg8::cvt_pk_bf16(b2[0], b2[1]); o.w = pg8::cvt_pk_bf16(b2[2], b2[3]);
              *(v4u*)(WSB + (size_t)i * 8) = o; } }
#ifndef P0_DEAL_A
#define P0_DEAL_A 13
#define P0_DEAL_B 29
#endif
        static_assert(1152 * P0_DEAL_A + 896 * P0_DEAL_B == 40960, "P0 deal");
        constexpr int I_GU = 32 * 176, I_D = 88 * 64, I_IN = 32 * 160, I_OUT = 32 * 64;
        constexpr int NTR = 6 * I_GU + I_IN + I_OUT;
        static_assert(I_GU == I_D && NTR == 40960, "item count");
        int t0, t1;
        if (NGW == 2048) { if (gw < 1152) { p0_ada_item(args.in[4], args.in[5], args.in[6], MODP, scr, gw, F.lane); t0 = gw * P0_DEAL_A; t1 = t0 + P0_DEAL_A; } else { t0 = 1152 * P0_DEAL_A + (gw - 1152) * P0_DEAL_B; t1 = t0 + P0_DEAL_B; } }
        else { for (int it = gw; it < 1152; it += NGW) p0_ada_item(args.in[4], args.in[5], args.in[6], MODP, scr, it, F.lane); const int per = (NTR + NGW - 1) / NGW; t0 = gw * per; t1 = min(t0 + per, NTR); }
        for (int it = t0; it < t1; ++it) {
            int r = it;
            if (r < I_GU) { p0_transpose_item<FFN_FP8>(args.in[9], DM, DFF, Wgu1, 1, scr, r, F.lane); continue; } r -= I_GU;
            if (r < I_GU) { p0_transpose_item<FFN_FP8>(args.in[10], DM, DFF, Wgu1, 2, scr, r, F.lane); continue; } r -= I_GU;
            if (r < I_D) { p0_transpose_item<FFN_FP8>(args.in[11], DFF, DM, Wd1, 0, scr, r, F.lane); continue; } r -= I_D;
            if (r < I_IN) { p0_transpose_item<false>(args.in[13], DM, INW, Win, 0, scr, r, F.lane); continue; } r -= I_IN;
            if (r < I_OUT) { p0_transpose_item<MIX_FP8>(args.in[20], DM, DM, Wout, 0, scr, r, F.lane); continue; } r -= I_OUT;
            if (r < I_GU) { p0_transpose_item<FFN_FP8>(args.in[22], DM, DFF, Wgu2, 1, scr, r, F.lane); continue; } r -= I_GU;
            if (r < I_GU) { p0_transpose_item<FFN_FP8>(args.in[23], DM, DFF, Wgu2, 2, scr, r, F.lane); continue; } r -= I_GU;
            p0_transpose_item<FFN_FP8>(args.in[24], DFF, DM, Wd2, 0, scr, r, F.lane);
        }
    }
    SEAM(0);
    if (IN(1)) REP(1) { REPBAR();
        const int gt = F.vcu * (NWAVES * 64) + F.tid, NGT = F.G * NWAVES * 64;
        for (int idx = gt; idx < NSET * NADA; idx += NGT) { const int j = idx / NADA, n = idx % NADA, chunk = n >> 11, col = n & 2047;
            float s = args.in[7][n];
#pragma unroll
            for (int ks = 0; ks < KSPLIT_ADA; ++ks) s += MODP[((size_t)(ks * NSET + j)) * NADA + n];
            const int sub = chunk / 3, kind = chunk % 3;
            if (kind == 1) { const float* gn = sub == 0 ? args.in[8] : sub == 1 ? args.in[12] : args.in[21]; s = gn[col] * (1.0f + s); }
            else if (kind == 2 && sub != 1) s *= 0.5f;
            MOD[(size_t)j * NADA + n] = s; }
    }
    SEAM(1);
    if (IN(2)) REP(2) { REPBAR();
        for (int m = gw; m < MTOK; m += NGW) { const int j = m < MCTX ? 0 : 1 + ((m - MCTX) >> 11);
            const float* xr = m < MCTX ? x_prompt + (size_t)m * DM : x_sample + (size_t)(m - MCTX) * DM;
            rownorm_mod_row<FFN_FP8>(const_cast<float*>(xr), nullptr, MOD + (size_t)j * NADA + 1 * DM, MOD + (size_t)j * NADA + 0 * DM, HB + (size_t)m * (FFN_FP8 ? DM / 2 : DM), F.lane); }
    }
    SEAM(2);
    if (IN(3)) REP(3) { REPBAR();
        pg8::Gemm g{HB, Wgu1, MTOK, 2 * DFF, FFN_FP8 ? DM / 2 : DM}; pg8::StaticOrder S; S.init(MTOK, 2 * DFF, F.G, (int)blockIdx.x);
#if FFN_FP8
        pg8::EpiSwiGLU8 E{(unsigned char*)ACT, DFF};
        pg8::gemm_phase<pg8::EpiSwiGLU8, pg8::StaticOrder, true, true, true>(F.lds + RING_OFF, g, S, E);
#else
        pg8::EpiSwiGLU E{ACT, DFF, 0};
#if PROBE_REPEAT == 3 && defined(PROBE_NULL_EPI)
        E.skip = rep_;
#endif
        pg8::gemm_phase<pg8::EpiSwiGLU, pg8::StaticOrder, true, true>(F.lds + RING_OFF, g, S, E);
#endif
    }
    SEAM(3);
    if (IN(4)) REP(4) { REPBAR();
        pg8::Gemm g{ACT, Wd1, MTOK, DM, FFN_FP8 ? DFF / 2 : DFF}; pg8::FlexOrder S; S.st.init(MTOK, DM, F.G, (int)blockIdx.x); S.sp.v = F.vcu; S.sp.nth = (FFN_FP8 ? DFF / 2 : DFF) / 128; S.split = split;
        pg8::EpiRes E{x_prompt, x_sample, xbuf, MOD + 2 * DM, DM, FFN_FP8 ? pg8::F8_DQ : 1.0f, PBUF};
        pg8::gemm_phase<pg8::EpiRes, pg8::FlexOrder, true, true, FFN_FP8>(F.lds + RING_OFF, g, S, E);
    }
    SEAM(4);
    if (IN(5)) REP(5) { REPBAR();
        for (int m = gw; m < MTOK; m += NGW) { const int j = m < MCTX ? 0 : 1 + ((m - MCTX) >> 11);
            rownorm_mod_row<false>(xbuf + (size_t)m * DM, (split && m >= 8192) ? PBUF + (size_t)(m - 8192) * DM : nullptr, MOD + (size_t)j * NADA + 4 * DM, MOD + (size_t)j * NADA + 3 * DM, HB + (size_t)m * DM, F.lane); }
    }
    SEAM(5);
    if (IN(6)) REP(6) { REPBAR();
        pg8::Gemm g{HB, Win, MTOK, INW, DM}; pg8::StaticOrder S; S.init(MTOK, INW, F.G, (int)blockIdx.x);
        pg8::EpiMixIn E{QB, KB, VB, UB, VGB, state_k, state_v, 0.125f * LOG2E_F};
        pg8::gemm_phase<pg8::EpiMixIn, pg8::StaticOrder, true, true>(F.lds + RING_OFF, g, S, E);
    }
    SEAM(6);
    if (IN(7)) REP(7) { REPBAR();
        const AttnArgs AT{QB, KB, VB, CKB, CVB, MIXB, args.in[14]};
        const GateArgs GT{UB, VGB, WSB, args.in[17], args.in[15], MIXB};
        REP(70) { REPBAR(); for (int u = F.vcu; u < 512; u += F.G) attn_unit(F.lds + RING_OFF, AT, true, u >> 7, (u >> 3) & 15, u & 7); }
        REP(71) { REPBAR(); for (int u = F.vcu; u < 256; u += F.G) attn_unit(F.lds + RING_OFF, AT, false, u >> 4, u & 15, 0); }
        REP(72) { REPBAR(); gate_units(F.lds + RING_OFF, GT, F.vcu, F.G, 768); }
    }
    SEAM(7);
#if SELFCHECK
    if (IN(8)) { selfcheck_mixer(F.lds + RING_OFF, gw, F.lane, F.wave, QB, KB, VB, CKB, CVB, UB, VGB, MIXB, args.in[14], args.in[16], args.in[17], args.in[15], (unsigned*)(F.ctl + 64)); xcd_barrier(bar); }
#endif
    if (IN(8)) REP(8) { REPBAR();
        for (int m = gw; m < MTOK; m += NGW) {
            v4u* rowp = (v4u*)(MIXB + (size_t)m * DM) + F.lane;
#pragma unroll
            for (int half = 0; half < 2; ++half) {
                v4u raw[2]; float v[16]; float ss = 0.f;
#pragma unroll
                for (int j = 0; j < 2; ++j) { raw[j] = rowp[half * 128 + 64 * j];
                    v[8 * j + 0] = bflo(raw[j].x); v[8 * j + 1] = bfhi(raw[j].x); v[8 * j + 2] = bflo(raw[j].y); v[8 * j + 3] = bfhi(raw[j].y);
                    v[8 * j + 4] = bflo(raw[j].z); v[8 * j + 5] = bfhi(raw[j].z); v[8 * j + 6] = bflo(raw[j].w); v[8 * j + 7] = bfhi(raw[j].w); }
#pragma unroll
                for (int e = 0; e < 16; ++e) ss += v[e] * v[e];
                const float rstd = 1.0f / sqrtf(wave_sum(ss) * (1.0f / WA) + EPS);
                const float* gn = args.in[18 + half];
#pragma unroll
                for (int j = 0; j < 2; ++j) { const f32x4 g0 = *(const f32x4*)(gn + (F.lane + 64 * j) * 8), g1 = *(const f32x4*)(gn + (F.lane + 64 * j) * 8 + 4);
#if MIX_FP8
                    const float rs8 = rstd * pg8::F8_SA; pg8::u32x2 w8; w8.x = pg8::pack4_fp8(v[8 * j + 0] * rs8 * g0[0], v[8 * j + 1] * rs8 * g0[1], v[8 * j + 2] * rs8 * g0[2], v[8 * j + 3] * rs8 * g0[3]);
                    w8.y = pg8::pack4_fp8(v[8 * j + 4] * rs8 * g1[0], v[8 * j + 5] * rs8 * g1[1], v[8 * j + 6] * rs8 * g1[2], v[8 * j + 7] * rs8 * g1[3]);
                    *((pg8::u32x2*)((unsigned char*)HB + (size_t)m * DM) + half * 128 + 64 * j + F.lane) = w8; }
#else
                    v4u w; w.x = pg8::cvt_pk_bf16(v[8 * j + 0] * rstd * g0[0], v[8 * j + 1] * rstd * g0[1]); w.y = pg8::cvt_pk_bf16(v[8 * j + 2] * rstd * g0[2], v[8 * j + 3] * rstd * g0[3]);
                    w.z = pg8::cvt_pk_bf16(v[8 * j + 4] * rstd * g1[0], v[8 * j + 5] * rstd * g1[1]); w.w = pg8::cvt_pk_bf16(v[8 * j + 6] * rstd * g1[2], v[8 * j + 7] * rstd * g1[3]);
                    rowp[half * 128 + 64 * j] = w; }
#endif
            }
        }
    }
    SEAM(8);
    if (IN(9)) REP(9) { REPBAR();
        pg8::Gemm g{MIX_FP8 ? HB : MIXB, Wout, MTOK, DM, MIX_FP8 ? DM / 2 : DM}; pg8::FlexOrder S; S.st.init(MTOK, DM, F.G, (int)blockIdx.x); S.sp.v = F.vcu; S.sp.nth = (MIX_FP8 ? DM / 2 : DM) / 128; S.split = split;
        pg8::EpiRes E{xbuf, xbuf + (size_t)MCTX * DM, xbuf, MOD + 5 * DM, DM, MIX_FP8 ? pg8::F8_DQ : 1.0f, PBUF};
        pg8::gemm_phase<pg8::EpiRes, pg8::FlexOrder, true, true, MIX_FP8>(F.lds + RING_OFF, g, S, E);
    }
    SEAM(9);
    if (IN(10)) REP(10) { REPBAR();
        for (int m = gw; m < MTOK; m += NGW) { const int j = m < MCTX ? 0 : 1 + ((m - MCTX) >> 11);
            rownorm_mod_row<FFN_FP8>(xbuf + (size_t)m * DM, (split && m >= 8192) ? PBUF + (size_t)(m - 8192) * DM : nullptr, MOD + (size_t)j * NADA + 7 * DM, MOD + (size_t)j * NADA + 6 * DM, HB + (size_t)m * (FFN_FP8 ? DM / 2 : DM), F.lane); }
    }
    SEAM(10);
    if (IN(11)) REP(11) { REPBAR();
        pg8::Gemm g{HB, Wgu2, MTOK, 2 * DFF, FFN_FP8 ? DM / 2 : DM}; pg8::StaticOrder S; S.init(MTOK, 2 * DFF, F.G, (int)blockIdx.x);
#if FFN_FP8
        pg8::EpiSwiGLU8 E{(unsigned char*)ACT, DFF};
        pg8::gemm_phase<pg8::EpiSwiGLU8, pg8::StaticOrder, true, true, true>(F.lds + RING_OFF, g, S, E);
#else
        pg8::EpiSwiGLU E{ACT, DFF, 0};
        pg8::gemm_phase<pg8::EpiSwiGLU, pg8::StaticOrder, true, true>(F.lds + RING_OFF, g, S, E);
#endif
    }
    SEAM(11);
    if (IN(12)) REP(12) { REPBAR();
        pg8::Gemm g{ACT, Wd2, MTOK, DM, FFN_FP8 ? DFF / 2 : DFF}; pg8::FlexOrder S; S.st.init(MTOK, DM, F.G, (int)blockIdx.x); S.sp.v = F.vcu; S.sp.nth = (FFN_FP8 ? DFF / 2 : DFF) / 128; S.split = split;
        pg8::EpiRes E{xbuf, xbuf + (size_t)MCTX * DM, xbuf, MOD + 8 * DM, DM, FFN_FP8 ? pg8::F8_DQ : 1.0f, PBUF};
        pg8::gemm_phase<pg8::EpiRes, pg8::FlexOrder, true, true, FFN_FP8>(F.lds + RING_OFF, g, S, E);
    }
    SEAM(12);
    if (IN(13)) REP(13) { REPBAR();
        const float* fg = args.in[25];
        for (int m = gw; m < MTOK; m += NGW) {
            GAS f32x4* xr = (GAS f32x4*)(xbuf + (size_t)m * DM) + F.lane;
            f32x4 v[8]; float s = 0.f;
#pragma unroll
            for (int j = 0; j < 8; ++j) v[j] = xr[64 * j];
            if (split && m >= 8192) { const GAS f32x4* pr = (const GAS f32x4*)(PBUF + (size_t)(m - 8192) * DM) + F.lane;
#pragma unroll
                for (int j = 0; j < 8; ++j) v[j] += pr[64 * j]; }
#pragma unroll
            for (int j = 0; j < 8; ++j) s += (v[j].x * v[j].x + v[j].y * v[j].y) + (v[j].z * v[j].z + v[j].w * v[j].w);
            const float rstd = 1.0f / sqrtf(wave_sum(s) * (1.0f / DM) + EPS);
#pragma unroll
            for (int j = 0; j < 8; ++j) xr[64 * j] = v[j] * rstd * *((const f32x4*)fg + F.lane + 64 * j);
        }
#if SELFCHECK
        if (gw == 0 && F.lane == 0) {
            const float e0 = __uint_as_float(__hip_atomic_load((unsigned*)(F.ctl + 64), RLX_AGENT)), e1 = __uint_as_float(__hip_atomic_load((unsigned*)(F.ctl + 65), RLX_AGENT)), e2 = __uint_as_float(__hip_atomic_load((unsigned*)(F.ctl + 66), RLX_AGENT));
#ifdef SELFCHECK_REPORT
            const int k = SELFCHECK_REPORT - 1; const float e = k == 0 ? e0 : k == 1 ? e1 : e2;
            xbuf[0] = (k == 0 ? 1e3f : k == 1 ? 1e5f : 1e7f) * (1.0f + 100.0f * fminf(e, 0.9f));
#else
            if (!(e0 < 0.03f)) xbuf[0] = 1e3f * (1.0f + 100.0f * fminf(e0, 0.9f));
            else if (!(e1 < 0.03f)) xbuf[0] = 1e5f * (1.0f + 100.0f * fminf(e1, 0.9f));
            else if (!(e2 < 0.05f)) xbuf[0] = 1e7f * (1.0f + 100.0f * fminf(e2, 0.9f));
#endif
        }
#endif
    }
#undef IN
#undef SEAM
}

#ifndef MK_N_LAUNCHES
#define MK_N_LAUNCHES 1
#endif
extern "C" void kernel_launch(void* const* d_in, const int* in_sizes, int n_in, void* d_out, int out_size, void* d_ws, size_t ws_size, hipStream_t stream) {
    static int grid = 0;
    if (grid == 0) {
        if (n_in != 26 || out_size != MTOK * DM + 2 * MCTX * WA || ws_size < WS_END) { fprintf(stderr, "kernel_launch: unexpected shapes: n_in %d out %d ws %zu (need %zu); nothing launched\n", n_in, out_size, ws_size, (size_t)WS_END); grid = -1; return; }
        int dev = 0, cus = 0, per_cu = 0;
        if (hipGetDevice(&dev) != hipSuccess || hipDeviceGetAttribute(&cus, hipDeviceAttributeMultiprocessorCount, dev) != hipSuccess) { fprintf(stderr, "kernel_launch: device query failed\n"); grid = -1; return; }
        if (hipFuncSetAttribute((const void*)mega_fwd, hipFuncAttributeMaxDynamicSharedMemorySize, LDS_BYTES) != hipSuccess) { fprintf(stderr, "kernel_launch: hipFuncSetAttribute failed\n"); grid = -1; return; }
        if (hipOccupancyMaxActiveBlocksPerMultiprocessor(&per_cu, (const void*)mega_fwd, NWAVES * 64, LDS_BYTES) != hipSuccess || per_cu < 1)
            fprintf(stderr, "kernel_launch: note: occupancy query reports %d workgroups per CU\n", per_cu);
        (void)hipGetLastError();
        grid = cus;
    }
    if (grid < 0) return;
    if (hipMemsetAsync((char*)d_ws + WS_CTL, 0, CTL_ZERO_BYTES, stream) != hipSuccess) { fprintf(stderr, "kernel_launch: hipMemsetAsync failed\n"); return; }
    Args a{};
    for (int i = 0; i < 26; ++i) a.in[i] = (const float*)d_in[i];
    a.out = (float*)d_out; a.ws = (unsigned char*)d_ws;
    if (MK_N_LAUNCHES == 1) { a.ph_lo = 0; a.ph_hi = N_PHASES; a.li = 0; hipLaunchKernelGGL(mega_fwd, dim3(grid), dim3(NWAVES * 64), LDS_BYTES, stream, a); }
    else { for (int p = 0; p < N_PHASES; ++p) { a.ph_lo = p; a.ph_hi = p + 1; a.li = 0; hipLaunchKernelGGL(mega_fwd, dim3(grid), dim3(NWAVES * 64), LDS_BYTES, stream, a); } }
    const hipError_t le = hipPeekAtLastError();
    if (le != hipSuccess) fprintf(stderr, "kernel_launch: launch failed: %s\n", hipGetErrorName(le));
}
```

```cpp
#include <hip/hip_runtime.h>
#include <cstdio>
#include <cstdint>
namespace pg8 {
#define PG8_LAS __attribute__((address_space(3)))
typedef unsigned short bf16_t;
typedef short bf16x8 __attribute__((ext_vector_type(8)));
typedef float f32x4 __attribute__((ext_vector_type(4)));
typedef unsigned u32x4 __attribute__((ext_vector_type(4)));
typedef int i32x4 __attribute__((ext_vector_type(4)));
typedef int i32x8 __attribute__((ext_vector_type(8)));
constexpr int BM = 256, BK = 64, HALF = 128, HTB = HALF * BK * 2  , STAGE_BYTES = 8 * HTB, NXCD = 8, WGM = 8;

__host__ __device__ __forceinline__ int lds_byte(int r, int c) { const int st = (r >> 4) * 2 + (c >> 5), rr = r & 15, cc = c & 31, ob = rr * 64 + cc * 2; return st * 1024 + (ob ^ (((ob >> 9) & 1) << 5)); }
__host__ __device__ __forceinline__ void stage_rc(int b, int& R, int& C) { const int st = b / 1024, sb = b % 1024, swz = sb ^ (((sb >> 9) & 1) << 5); R = (st >> 1) * 16 + swz / 64; C = (st & 1) * 32 + (swz % 64) / 2; }
__host__ __device__ __forceinline__ int perm32(int rho) { const int n = rho >> 4, i = rho & 15; return 8 * (i >> 2) + 4 * n + (i & 3); }

struct Unit { int pm, pn, k0, nt, part; };
struct Gemm { const bf16_t* A; const bf16_t* Bt; int M, N, K; };

struct StaticOrder {
    int nM, nN, nwg, G, c;
    __host__ __device__ void init(int M, int N, int G_, int c_) { nM = M / BM; nN = N / BM; nwg = nM * nN; G = G_; c = c_; }
    __host__ __device__ bool next(int i, Unit& u) const {
        const long L = (long)i * G + c; if (L >= nwg) return false;
        int wgid = (int)L; { const int q = nwg / NXCD, r = nwg % NXCD, xcd = wgid % NXCD, off = wgid / NXCD; wgid = (xcd < r ? xcd * (q + 1) : r * (q + 1) + (xcd - r) * q) + off; }
        const int nig = WGM * nN, gid = wgid / nig, fm = gid * WGM, gsz = (nM - fm) < WGM ? (nM - fm) : WGM;
        u.pm = fm + ((wgid % nig) % gsz); u.pn = (wgid % nig) / gsz; u.k0 = 0; u.nt = 0; u.part = 0; return true;
    }
    __device__ __forceinline__ void a_ready(const Unit&) const {}
    __device__ __forceinline__ void done(const Unit&) const {}
};
struct SplitOrder {
    int v, nth;
    __device__ __forceinline__ bool next(int i, Unit& u) const {
        if (i == 0) { u.pm = v >> 3; u.pn = v & 7; u.k0 = 0; u.nt = 0; u.part = 0; return true; }
        if (i == 1) { const int s = v >> 1, half = v & 1; u.pm = 32 + (s >> 3); u.pn = s & 7; u.k0 = half * nth; u.nt = nth; u.part = half; return true; }
        return false;
    }
    __device__ __forceinline__ void a_ready(const Unit&) const {}
    __device__ __forceinline__ void done(const Unit&) const {}
};
struct FlexOrder {
    StaticOrder st; SplitOrder sp; bool split;
    __device__ __forceinline__ bool next(int i, Unit& u) const { return split ? sp.next(i, u) : st.next(i, u); }
    __device__ __forceinline__ void a_ready(const Unit&) const {}
    __device__ __forceinline__ void done(const Unit&) const {}
};
struct MixOrder {
    int c; bool use_static; StaticOrder st;
    __device__ __forceinline__ bool next(int i, Unit& u) const {
        if (use_static) return st.next(i, u);
        const int x = c & 7, k = c >> 3; int off, kmin;
        if (i == 0) { off = 0; kmin = 0; } else if (i == 1) { off = 32; kmin = 0; } else if (i == 2) { off = 64; kmin = 8; } else if (i == 3) { off = 88; kmin = 16; } else return false;
        if (k < kmin) return false;
        const int T = 104 * x + off + (k - kmin);
        if (T < 640) { const int gid = T / 160, w = T % 160; u.pm = 16 + 8 * gid + (w & 7); u.pn = w >> 3; }
        else { const int t2 = T - 640, gid = t2 / 96, w = t2 % 96, j = w >> 3; u.pm = 8 * gid + (w & 7); u.pn = j < 4 ? j : j + 8; }
        u.k0 = 0; u.nt = 0; u.part = 0; return true;
    }
    __device__ __forceinline__ void a_ready(const Unit&) const {}
    __device__ __forceinline__ void done(const Unit&) const {}
};


__device__ __forceinline__ unsigned cvt_pk_bf16(float lo, float hi) { unsigned r; asm volatile("v_cvt_pk_bf16_f32 %0, %1, %2" : "=v"(r) : "v"(lo), "v"(hi)); return r; }
typedef float f32x2 __attribute__((ext_vector_type(2)));
typedef unsigned u32x2 __attribute__((ext_vector_type(2)));
constexpr float LOG2E = 1.4426950408889634f;
__device__ __forceinline__ float silu_f(float g) { return g * __builtin_amdgcn_rcpf(1.0f + __builtin_amdgcn_exp2f(-LOG2E * g)); }
__device__ __forceinline__ float gelu_tanh_f(float x) { const float t = x * (-2.3022081983f + -0.1029432407f * x * x); return x * __builtin_amdgcn_rcpf(1.0f + __builtin_amdgcn_exp2f(t)); }

__device__ __forceinline__ int mod_set_of_tile(int pm) { return pm < 16 ? 0 : 1 + ((pm - 16) >> 3); }
constexpr int MOD_JSTRIDE = 9 * 2048;

__device__ __forceinline__ unsigned pack4_fp8(float a, float b, float c, float d) {
    a = __builtin_fminf(__builtin_fmaxf(a, -448.f), 448.f); b = __builtin_fminf(__builtin_fmaxf(b, -448.f), 448.f);
    c = __builtin_fminf(__builtin_fmaxf(c, -448.f), 448.f); d = __builtin_fminf(__builtin_fmaxf(d, -448.f), 448.f);
    int p = __builtin_amdgcn_cvt_pk_fp8_f32(a, b, 0, false); p = __builtin_amdgcn_cvt_pk_fp8_f32(c, d, p, true); return (unsigned)p;
}
constexpr float F8_SA = 8.0f, F8_SW = 128.0f, F8_DQ = 1.0f / (F8_SA * F8_SW);
struct EpiSwiGLU8 {
    static constexpr bool PERM = true, AFTER_DRAIN = false;
    unsigned char* O; int ldc;
    __device__ __forceinline__ void operator()(const f32x4 (&acc)[2][2][4][2], const Unit& u, int wr, int wc, int fr, int fq) const {
        const int row0 = u.pm * BM + wr * 64 + fr, col0 = u.pn * HALF + wc * 32 + 8 * fq;
#pragma unroll
        for (int ai = 0; ai < 2; ++ai)
#pragma unroll
            for (int m = 0; m < 4; ++m) { unsigned char* rowp = O + (size_t)(row0 + ai * HALF + m * 16) * ldc + col0;
                const f32x4 g0 = acc[ai][0][m][0] * F8_DQ, g1 = acc[ai][0][m][1] * F8_DQ, u0 = acc[ai][1][m][0] * (F8_DQ * F8_SA), u1 = acc[ai][1][m][1] * (F8_DQ * F8_SA);
                u32x2 w; w.x = pack4_fp8(silu_f(g0[0]) * u0[0], silu_f(g0[1]) * u0[1], silu_f(g0[2]) * u0[2], silu_f(g0[3]) * u0[3]);
                w.y = pack4_fp8(silu_f(g1[0]) * u1[0], silu_f(g1[1]) * u1[1], silu_f(g1[2]) * u1[2], silu_f(g1[3]) * u1[3]);
                *(u32x2*)rowp = w; }
    }
};

struct EpiSwiGLU {
    static constexpr bool PERM = true, AFTER_DRAIN = false;
    bf16_t* O; int ldc; int skip;
    __device__ __forceinline__ void operator()(const f32x4 (&acc)[2][2][4][2], const Unit& u, int wr, int wc, int fr, int fq) const {
#if defined(PROBE_NULL_EPI)
        if (skip) {
#pragma unroll
            for (int ai = 0; ai < 2; ++ai)
#pragma unroll
                for (int bj = 0; bj < 2; ++bj)
#pragma unroll
                    for (int m = 0; m < 4; ++m)
#pragma unroll
                        for (int n = 0; n < 2; ++n) asm volatile("" :: "v"(acc[ai][bj][m][n]));
            return; }
#endif
        const int row0 = u.pm * BM + wr * 64 + fr, col0 = u.pn * HALF + wc * 32 + 8 * fq;
#pragma unroll
        for (int ai = 0; ai < 2; ++ai)
#pragma unroll
            for (int m = 0; m < 4; ++m) { bf16_t* rowp = O + (size_t)(row0 + ai * HALF + m * 16) * ldc + col0;
                const f32x4 g0 = acc[ai][0][m][0], g1 = acc[ai][0][m][1], u0 = acc[ai][1][m][0], u1 = acc[ai][1][m][1];
                u32x4 w; w.x = cvt_pk_bf16(silu_f(g0[0]) * u0[0], silu_f(g0[1]) * u0[1]); w.y = cvt_pk_bf16(silu_f(g0[2]) * u0[2], silu_f(g0[3]) * u0[3]);
                w.z = cvt_pk_bf16(silu_f(g1[0]) * u1[0], silu_f(g1[1]) * u1[1]); w.w = cvt_pk_bf16(silu_f(g1[2]) * u1[2], silu_f(g1[3]) * u1[3]);
                *(u32x4*)rowp = w; }
    }
};

struct EpiRes {
    static constexpr bool PERM = false, AFTER_DRAIN = false;
    const float* base_ctx; const float* base_lat; float* out; const float* gtab; int ldc; float dq; float* pbuf;
    __device__ __forceinline__ void operator()(const f32x4 (&acc)[2][2][4][2], const Unit& u, int wr, int wc, int fr, int fq) const {
        const int row0 = u.pm * BM + wr * 64 + fr, col0 = u.pn * BM + wc * 32 + 4 * fq;
        const float* gv = gtab + (size_t)mod_set_of_tile(u.pm) * MOD_JSTRIDE;
        const float* bbase = u.pm < 16 ? base_ctx : base_lat; const int brow0 = u.pm < 16 ? row0 : row0 - 4096;
        f32x4 gvv[2][2];
#pragma unroll
        for (int bj = 0; bj < 2; ++bj)
#pragma unroll
            for (int n = 0; n < 2; ++n) gvv[bj][n] = *(const f32x4*)(gv + col0 + bj * HALF + n * 16) * dq;
#pragma unroll
        for (int ai = 0; ai < 2; ++ai)
#pragma unroll
            for (int m = 0; m < 4; ++m) { const size_t boff = (size_t)(brow0 + ai * HALF + m * 16) * ldc + col0, ooff = (size_t)(row0 + ai * HALF + m * 16) * ldc + col0;
#pragma unroll
                for (int bj = 0; bj < 2; ++bj)
#pragma unroll
                    for (int n = 0; n < 2; ++n) {
                        if (u.part) *(f32x4*)(pbuf + ooff - (size_t)8192 * ldc + bj * HALF + n * 16) = gvv[bj][n] * acc[ai][bj][m][n];
                        else { const f32x4 bs = *(const f32x4*)(bbase + boff + bj * HALF + n * 16);
                            *(f32x4*)(out + ooff + bj * HALF + n * 16) = bs + gvv[bj][n] * acc[ai][bj][m][n]; } } }
    }
};

constexpr size_t REGION_STRIDE = (size_t)24 * 1024 * 1024 / 2;
struct EpiMixIn {
    static constexpr bool PERM = true, AFTER_DRAIN = false;
    bf16_t* qb; bf16_t* kb; bf16_t* vb; bf16_t* ub; bf16_t* vgb; float* state_k; float* state_v; float qscale; int pn_off; float dq;
    __device__ __forceinline__ void operator()(const f32x4 (&acc)[2][2][4][2], const Unit& u, int wr, int wc, int fr, int fq) const {
        const int row0 = u.pm * BM + wr * 64 + fr;
#pragma unroll
        for (int bj = 0; bj < 2; ++bj) {
            const int colg = (u.pn + pn_off) * BM + bj * HALF, region = colg >> 10, cb = (colg & 1023) + wc * 32 + 8 * fq;
            bf16_t* dst = qb + (size_t)region * REGION_STRIDE;
            float* st = state_k + (size_t)(region == 2 ? 4096 * 1024 : 0); const bool wst = (region == 1 || region == 2) && u.pm < 16;
            if (wst && !state_k) continue;
#pragma unroll
            for (int ai = 0; ai < 2; ++ai)
#pragma unroll
                for (int m = 0; m < 4; ++m) { const int row = row0 + ai * HALF + m * 16; f32x4 v0 = acc[ai][bj][m][0] * dq, v1 = acc[ai][bj][m][1] * dq;
                    if (wst) { *(f32x4*)(st + (size_t)row * 1024 + cb) = v0; *(f32x4*)(st + (size_t)row * 1024 + cb + 4) = v1; }
                    if (region == 0) { v0 = v0 * qscale; v1 = v1 * qscale; }
                    if (region >= 3) {
#pragma unroll
                        for (int i = 0; i < 4; ++i) { v0[i] = gelu_tanh_f(v0[i]); v1[i] = gelu_tanh_f(v1[i]); } }
                    u32x4 w; w.x = cvt_pk_bf16(v0[0], v0[1]); w.y = cvt_pk_bf16(v0[2], v0[3]); w.z = cvt_pk_bf16(v1[0], v1[1]); w.w = cvt_pk_bf16(v1[2], v1[3]);
                    *(u32x4*)(dst + (size_t)row * 1024 + cb) = w; }
        }
    }
};

struct EpiNull {
    static constexpr bool PERM = true, AFTER_DRAIN = false;
    __device__ __forceinline__ void operator()(const f32x4 (&acc)[2][2][4][2], const Unit& u, int wr, int wc, int fr, int fq) const {
#pragma unroll
        for (int ai = 0; ai < 2; ++ai)
#pragma unroll
            for (int bj = 0; bj < 2; ++bj)
#pragma unroll
                for (int m = 0; m < 4; ++m)
#pragma unroll
                    for (int n = 0; n < 2; ++n) asm volatile("" :: "v"(acc[ai][bj][m][n]));
    }
};

template <class Epi, class Sched, bool ALIGN_EPI = false, bool SP2 = false, bool F8 = false>
__device__ __forceinline__ void gemm_phase(PG8_LAS unsigned char* lds, const Gemm g, const Sched& S, const Epi& E) {
    const int tid = threadIdx.x, wid = __builtin_amdgcn_readfirstlane(tid >> 6), lane = tid & 63, wr = wid >> 2, wc = wid & 3, fr = lane & 15, fq = lane >> 4;
    const int K = g.K, nt_full = K / BK; int nt = nt_full;
    unsigned voffA[2], voffB[2];
#pragma unroll
    for (int i = 0; i < 2; ++i) { int R, C; stage_rc(tid * 16 + i * 8192, R, C); const int Rb = Epi::PERM ? ((R & ~31) + perm32(R & 31)) : R;
        voffA[i] = (unsigned)(R * K + C) * 2u; voffB[i] = (unsigned)(Rb * K + C) * 2u; }
    const size_t kstep = (size_t)(BK * 2);
    const size_t hstep = (size_t)HALF * K * 2;
    const size_t tstep = 2 * hstep;
    const unsigned ldsw = (unsigned)wid * 1024u;
    const int aoff = lds_byte(wr * 64 + fr, fq * 8), boff = lds_byte(wc * 32 + fr, fq * 8);
    const int a8 = lds_byte(wr * 64 + fr, fq * 16), b8 = lds_byte(wc * 32 + fr, fq * 16);
    const int aoffk0 = F8 ? a8 + (fq & 1) * 16 : aoff, aoffk1 = F8 ? a8 + ((fq & 1) ^ 1) * 16 : aoff + 1024;
    const int boffk0 = F8 ? b8 + (fq & 1) * 16 : boff, boffk1 = F8 ? b8 + ((fq & 1) ^ 1) * 16 : boff + 1024;
#define PG8_SA(b, h) (((b) * 2 + (h)) * HTB)
#define PG8_SB(b, h) ((4 + (b) * 2 + (h)) * HTB)
#define PG8_STAGE(bufoff, gbase, voff) do { _Pragma("unroll") for (int _i = 0; _i < 2; ++_i) \
        __builtin_amdgcn_global_load_lds((const unsigned*)((const char*)(gbase) + (voff)[_i]), (PG8_LAS unsigned*)(lds + (bufoff) + ldsw + _i * 8192), 16, 0, 0); } while (0)
#define PG8_LDA(dst, b, h) do { _Pragma("unroll") for (int m = 0; m < 4; ++m) { dst[m][0] = *(const PG8_LAS bf16x8*)(lds + PG8_SA(b, h) + aoffk0 + m * 2048); dst[m][1] = *(const PG8_LAS bf16x8*)(lds + PG8_SA(b, h) + aoffk1 + m * 2048); } } while (0)
#define PG8_LDB(dst, b, h) do { _Pragma("unroll") for (int n = 0; n < 2; ++n) { dst[n][0] = *(const PG8_LAS bf16x8*)(lds + PG8_SB(b, h) + boffk0 + n * 2048); dst[n][1] = *(const PG8_LAS bf16x8*)(lds + PG8_SB(b, h) + boffk1 + n * 2048); } } while (0)
#define PG8_CAT8(x) __builtin_shufflevector(__builtin_bit_cast(i32x4, (x)[0]), __builtin_bit_cast(i32x4, (x)[1]), 0, 1, 2, 3, 4, 5, 6, 7)
#define PG8_MMA(ai, bj, At, Bt) do { __builtin_amdgcn_s_setprio(1); _Pragma("unroll") for (int m = 0; m < 4; ++m) _Pragma("unroll") for (int n = 0; n < 2; ++n) { \
        if constexpr (F8) { const i32x8 b8_ = PG8_CAT8(Bt[n]), a8_ = PG8_CAT8(At[m]); asm volatile("v_mfma_f32_16x16x128_f8f6f4 %0, %1, %2, %0" : "+v"(acc[ai][bj][m][n]) : "v"(b8_), "v"(a8_)); } \
        else { _Pragma("unroll") for (int k = 0; k < 2; ++k) acc[ai][bj][m][n] = __builtin_amdgcn_mfma_f32_16x16x32_bf16(Bt[n][k], At[m][k], acc[ai][bj][m][n], 0, 0, 0); } } \
        __builtin_amdgcn_s_setprio(0); } while (0)
#define PG8_WAIT_V(n) asm volatile("s_waitcnt vmcnt(" #n ")" ::: "memory")
#define PG8_WAIT_L(n) asm volatile("s_waitcnt lgkmcnt(" #n ")" ::: "memory")
#define PG8_BAR __builtin_amdgcn_s_barrier()
#define PG8_SCHED __builtin_amdgcn_sched_barrier(0)
    Unit cur, nxt; int ui = 0;
    if (!S.next(0, cur)) return;
    f32x4 acc[2][2][4][2];
#pragma unroll
    for (int a = 0; a < 2; ++a)
#pragma unroll
        for (int b = 0; b < 2; ++b)
#pragma unroll
            for (int m = 0; m < 4; ++m)
#pragma unroll
                for (int n = 0; n < 2; ++n) acc[a][b][m][n] = (f32x4){0.f, 0.f, 0.f, 0.f};
    bf16x8 At[4][2], B0[2][2], B1[2][2];
    const char* cA = (const char*)g.A + (size_t)cur.pm * tstep + (size_t)cur.k0 * kstep; const char* cB = (const char*)g.Bt + (size_t)cur.pn * tstep + (size_t)cur.k0 * kstep;
    nt = cur.nt ? cur.nt : nt_full;
    S.a_ready(cur);
    if constexpr (SP2) {
        PG8_STAGE(PG8_SB(0, 0), cB, voffB); PG8_STAGE(PG8_SB(0, 1), cB + hstep, voffB); PG8_STAGE(PG8_SA(0, 0), cA, voffA); PG8_STAGE(PG8_SA(0, 1), cA + hstep, voffA);
        if (wr == 1) PG8_BAR;
        PG8_WAIT_V(2); PG8_BAR;
        PG8_STAGE(PG8_SB(1, 0), cB + kstep, voffB); PG8_STAGE(PG8_SA(1, 0), cA + kstep, voffA); PG8_STAGE(PG8_SB(1, 1), cB + hstep + kstep, voffB);
        PG8_WAIT_V(6); PG8_BAR;
    } else {
        PG8_STAGE(PG8_SB(0, 0), cB, voffB); PG8_STAGE(PG8_SA(0, 0), cA, voffA); PG8_STAGE(PG8_SB(0, 1), cB + hstep, voffB); PG8_STAGE(PG8_SA(0, 1), cA + hstep, voffA);
        if (wr == 1) PG8_BAR;
        PG8_WAIT_V(4); PG8_BAR;
        PG8_STAGE(PG8_SB(1, 0), cB + kstep, voffB); PG8_STAGE(PG8_SA(1, 0), cA + kstep, voffA); PG8_STAGE(PG8_SB(1, 1), cB + hstep + kstep, voffB);
        PG8_WAIT_V(6); PG8_BAR;
    }
    for (;;) {
        const bool has_next = S.next(ui + 1, nxt);
        const char* nA = has_next ? (const char*)g.A + (size_t)nxt.pm * tstep + (size_t)nxt.k0 * kstep : cA; const char* nB = has_next ? (const char*)g.Bt + (size_t)nxt.pn * tstep + (size_t)nxt.k0 * kstep : cB;
        for (int t = 0; t < nt; t += 2) {
            const bool last = (t == nt - 2);
            const char* a1 = cA + (size_t)(t + 1) * kstep;
            const char* a2 = last ? nA : cA + (size_t)(t + 2) * kstep; const char* b2 = last ? nB : cB + (size_t)(t + 2) * kstep;
            const char* a3 = a2 + kstep; const char* b3 = b2 + kstep;
            if (last && has_next) S.a_ready(nxt);
            if constexpr (SP2) {
            PG8_LDB(B0, 0, 0); PG8_LDB(B1, 0, 1); PG8_SCHED; PG8_LDA(At, 0, 0); PG8_STAGE(PG8_SA(1, 1), a1 + hstep, voffA);
            PG8_WAIT_V(8); PG8_WAIT_L(0); PG8_BAR; PG8_MMA(0, 0, At, B0); PG8_MMA(0, 1, At, B1); PG8_BAR; PG8_SCHED;
            PG8_LDA(At, 0, 1); PG8_STAGE(PG8_SB(0, 0), b2, voffB); PG8_STAGE(PG8_SB(0, 1), b2 + hstep, voffB); PG8_STAGE(PG8_SA(0, 0), a2, voffA);
            PG8_WAIT_V(8); PG8_WAIT_L(0); PG8_BAR; PG8_MMA(1, 0, At, B0); PG8_MMA(1, 1, At, B1); PG8_BAR; PG8_SCHED;
            PG8_LDB(B0, 1, 0); PG8_LDB(B1, 1, 1); PG8_SCHED; PG8_LDA(At, 1, 0); PG8_STAGE(PG8_SA(0, 1), a2 + hstep, voffA);
            PG8_WAIT_V(8); PG8_WAIT_L(0); PG8_BAR; PG8_MMA(0, 0, At, B0); PG8_MMA(0, 1, At, B1); PG8_BAR; PG8_SCHED;
            PG8_LDA(At, 1, 1); PG8_STAGE(PG8_SB(1, 0), b3, voffB); PG8_STAGE(PG8_SB(1, 1), b3 + hstep, voffB); PG8_STAGE(PG8_SA(1, 0), a3, voffA);
            PG8_WAIT_V(8); PG8_WAIT_L(0); PG8_BAR; PG8_MMA(1, 0, At, B0); PG8_MMA(1, 1, At, B1); PG8_BAR; PG8_SCHED;
            } else {
            PG8_LDB(B0, 0, 0); PG8_SCHED; PG8_LDA(At, 0, 0); PG8_STAGE(PG8_SA(1, 1), a1 + hstep, voffA);
            PG8_WAIT_L(8); PG8_BAR; PG8_WAIT_L(0); PG8_MMA(0, 0, At, B0); PG8_BAR; PG8_SCHED;
            PG8_LDB(B1, 0, 1); PG8_STAGE(PG8_SB(0, 0), b2, voffB);
            PG8_BAR; PG8_WAIT_L(0); PG8_MMA(0, 1, At, B1); PG8_BAR;
            PG8_LDA(At, 0, 1); PG8_STAGE(PG8_SA(0, 0), a2, voffA);
            PG8_BAR; PG8_WAIT_L(0); PG8_MMA(1, 0, At, B0); PG8_BAR; PG8_SCHED;
            PG8_STAGE(PG8_SB(0, 1), b2 + hstep, voffB);
            PG8_WAIT_V(6); PG8_BAR; PG8_MMA(1, 1, At, B1); PG8_BAR;
            PG8_LDB(B0, 1, 0); PG8_SCHED; PG8_LDA(At, 1, 0); PG8_STAGE(PG8_SA(0, 1), a2 + hstep, voffA);
            PG8_WAIT_L(8); PG8_BAR; PG8_WAIT_L(0); PG8_MMA(0, 0, At, B0); PG8_BAR; PG8_SCHED;
            PG8_LDB(B1, 1, 1); PG8_STAGE(PG8_SB(1, 0), b3, voffB);
            PG8_BAR; PG8_WAIT_L(0); PG8_MMA(0, 1, At, B1); PG8_BAR;
            PG8_LDA(At, 1, 1); PG8_STAGE(PG8_SA(1, 0), a3, voffA);
            PG8_BAR; PG8_WAIT_L(0); PG8_MMA(1, 0, At, B0); PG8_BAR; PG8_SCHED;
            PG8_STAGE(PG8_SB(1, 1), b3 + hstep, voffB);
            PG8_WAIT_V(6); PG8_BAR; PG8_MMA(1, 1, At, B1); PG8_BAR;
            }
        }
        if constexpr (ALIGN_EPI) { if (wr == 0) PG8_BAR; }
        if constexpr (F8) {
            asm volatile("s_nop 15\n\ts_nop 15" : "+v"(acc[0][0][0][0]), "+v"(acc[0][0][0][1]), "+v"(acc[0][0][1][0]), "+v"(acc[0][0][1][1]), "+v"(acc[0][0][2][0]), "+v"(acc[0][0][2][1]), "+v"(acc[0][0][3][0]), "+v"(acc[0][0][3][1]),
                         "+v"(acc[0][1][0][0]), "+v"(acc[0][1][0][1]), "+v"(acc[0][1][1][0]), "+v"(acc[0][1][1][1]), "+v"(acc[0][1][2][0]), "+v"(acc[0][1][2][1]), "+v"(acc[0][1][3][0]), "+v"(acc[0][1][3][1]));
            asm volatile("s_nop 15\n\ts_nop 15" : "+v"(acc[1][0][0][0]), "+v"(acc[1][0][0][1]), "+v"(acc[1][0][1][0]), "+v"(acc[1][0][1][1]), "+v"(acc[1][0][2][0]), "+v"(acc[1][0][2][1]), "+v"(acc[1][0][3][0]), "+v"(acc[1][0][3][1]),
                         "+v"(acc[1][1][0][0]), "+v"(acc[1][1][0][1]), "+v"(acc[1][1][1][0]), "+v"(acc[1][1][1][1]), "+v"(acc[1][1][2][0]), "+v"(acc[1][1][2][1]), "+v"(acc[1][1][3][0]), "+v"(acc[1][1][3][1])); }
        if constexpr (!Epi::AFTER_DRAIN) { E(acc, cur, wr, wc, fr, fq); S.done(cur); }
        if (!has_next) break;
#pragma unroll
        for (int a = 0; a < 2; ++a)
#pragma unroll
            for (int b = 0; b < 2; ++b)
#pragma unroll
                for (int m = 0; m < 4; ++m)
#pragma unroll
                    for (int n = 0; n < 2; ++n) acc[a][b][m][n] = (f32x4){0.f, 0.f, 0.f, 0.f};
        cur = nxt; cA = nA; cB = nB; ++ui; nt = cur.nt ? cur.nt : nt_full;
        if constexpr (ALIGN_EPI) { if (wr == 1) PG8_BAR; }
    }
    PG8_WAIT_V(0);
    if constexpr (!ALIGN_EPI) { if (wr == 0) PG8_BAR; }
    PG8_BAR;
    if constexpr (Epi::AFTER_DRAIN) { E.fused(acc, cur, wr, wc, fr, fq, lds, wid, lane); S.done(cur); }
#undef PG8_SA
#undef PG8_SB
#undef PG8_STAGE
#undef PG8_LDA
#undef PG8_LDB
#undef PG8_MMA
#undef PG8_CAT8
#undef PG8_WAIT_V
#undef PG8_WAIT_L
#undef PG8_BAR
#undef PG8_SCHED
}
}
#define GAS __attribute__((address_space(1)))
#define LAS __attribute__((address_space(3)))
typedef unsigned short bf16;
typedef unsigned v4u __attribute__((ext_vector_type(4)));
typedef float f32x4 __attribute__((ext_vector_type(4)));
typedef short bf16x8 __attribute__((ext_vector_type(8)));
typedef GAS unsigned gu32;
typedef GAS unsigned long long gu64;
#define RLX_AGENT __ATOMIC_RELAXED, __HIP_MEMORY_SCOPE_AGENT
#define LDS_WAIT() asm volatile("s_waitcnt lgkmcnt(0)" ::: "memory")
#define VM_WAIT() asm volatile("s_waitcnt vmcnt(0)" ::: "memory")
__device__ __forceinline__ unsigned long long rt() { return __builtin_amdgcn_s_memrealtime(); }
__device__ __forceinline__ unsigned f2bf(float f) { unsigned u = __builtin_bit_cast(unsigned, f); return (u + 0x7fffu + ((u >> 16) & 1u)) >> 16; }
__device__ __forceinline__ unsigned pk2(float lo, float hi) { return f2bf(lo) | (f2bf(hi) << 16); }

#define XB_TMO      128
#define XB_XCNT(j)  (256  + 64 * (j))
#define XB_XSUB(j)  (1280 + 64 * (j))
#define XB_XGEN(j)  (2304 + 64 * (j))
#define XB_TOP      3328
#define XB_TOPGEN   3392
#define XCD_BAR_WORDS 3456
#define XB_SPIN_CAP (1u << 18)

__device__ __forceinline__ unsigned xb_ld(unsigned* p)              { return __hip_atomic_load(p, __ATOMIC_RELAXED, __HIP_MEMORY_SCOPE_AGENT); }
__device__ __forceinline__ unsigned xb_add(unsigned* p, unsigned v) { return __hip_atomic_fetch_add(p, v, __ATOMIC_RELAXED, __HIP_MEMORY_SCOPE_AGENT); }
__device__ __forceinline__ unsigned xb_xcc_id() { return (unsigned)__builtin_amdgcn_s_getreg((3 << 11) | 20) & 0xFu; }
#define XB_SPIN(cond, bar) do { unsigned _sp = 0; while (cond) { __builtin_amdgcn_s_sleep(1); \
    if ((++_sp & 255u) == 0u) { if (xb_ld(&(bar)[XB_TMO])) break; if (_sp > XB_SPIN_CAP) { atomicAdd(&(bar)[XB_TMO], 1u); break; } } } } while (0)

struct XcdBarrier {
    unsigned* bar; unsigned x;
    volatile LAS unsigned* st;
};

__device__ __forceinline__ XcdBarrier xcd_barrier_post(unsigned* bar, volatile LAS unsigned* st) {
    XcdBarrier b; b.bar = bar; b.x = xb_xcc_id(); b.st = st;
    if (threadIdx.x == 0) (void)xb_add(&bar[XB_XCNT(b.x)], 1u);
    return b;
}
__device__ __forceinline__ void xcd_barrier_complete(unsigned* bar, unsigned x, unsigned& nloc, unsigned& nx) {
    const unsigned G = gridDim.x * gridDim.y * gridDim.z;
    unsigned sum, cnt, mine, sp = 0u;
    for (;;) {
        sum = 0u; cnt = 0u; mine = 0u;
#pragma unroll
        for (unsigned j = 0; j < 16; ++j) { const unsigned c = xb_ld(&bar[XB_XCNT(j)]); sum += c; cnt += (c > 0u) ? 1u : 0u; mine = (j == x) ? c : mine; }
        if (sum == G) break;
        __builtin_amdgcn_s_sleep(1);
        if ((++sp & 255u) == 0u) { if (xb_ld(&bar[XB_TMO])) break; if (sp > XB_SPIN_CAP) { atomicAdd(&bar[XB_TMO], 1u); break; } }
    }
    nloc = mine > 0u ? mine : 1u; nx = cnt > 0u ? cnt : 1u;
}

__device__ __forceinline__ void xcd_barrier(const XcdBarrier& b) {
    asm volatile("s_waitcnt vmcnt(0)" ::: "memory");
    __syncthreads();
    if (threadIdx.x == 0) {
        unsigned* bar = b.bar;
        __builtin_amdgcn_s_waitcnt(0);
        unsigned nloc = b.st[0], nx = b.st[1];
        if (nloc == 0u) { xcd_barrier_complete(bar, b.x, nloc, nx); b.st[0] = nloc; b.st[1] = nx; }
        const unsigned old = xb_add(&bar[XB_XSUB(b.x)], 1u);
        const unsigned gen = old / nloc;
        if (old + 1u == (gen + 1u) * nloc) {
            __builtin_amdgcn_fence(__ATOMIC_RELEASE, "agent");
            asm volatile("s_waitcnt vmcnt(0)" ::: "memory");
            const unsigned og = xb_add(&bar[XB_TOP], 1u);
            const unsigned tg = og / nx;
            if (og + 1u == (tg + 1u) * nx) xb_add(&bar[XB_TOPGEN], 1u);
            else XB_SPIN(xb_ld(&bar[XB_TOPGEN]) == tg, bar);
            __builtin_amdgcn_fence(__ATOMIC_ACQUIRE, "agent");
            xb_add(&bar[XB_XGEN(b.x)], 1u);
            asm volatile("s_waitcnt vmcnt(0)" ::: "memory");
        } else {
            XB_SPIN(xb_ld(&bar[XB_XGEN(b.x)]) == gen, bar);
            __builtin_amdgcn_fence(__ATOMIC_ACQUIRE, "agent");
            asm volatile("s_waitcnt vmcnt(0)" ::: "memory");
        }
    }
    __syncthreads();
}

constexpr int NWAVES = 8;
constexpr int DM = 2048, MCTX = 4096, MLAT = 8192, MTOK = MCTX + MLAT, DFF = 5632, INW = 5120, WA = 1024, NADA = 9 * DM;
constexpr float EPS = 1e-6f;
constexpr float LOG2E_F = 1.4426950408889634f;
constexpr int KSPLIT_ADA = 16, ADA_ROWS = DM / KSPLIT_ADA;
#ifndef MIX_FP8
#define MIX_FP8 1
#endif
#ifndef FFN_FP8
#define FFN_FP8 1
#endif
constexpr int NSET = 5;

constexpr size_t MiB = 1u << 20;
constexpr size_t WS_CTL = 0, CTL_ZERO_BYTES = 1 * MiB;
constexpr size_t WS_MODP = 1 * MiB;
constexpr size_t WS_MOD = 7 * MiB;
constexpr size_t WS_WSB = 7 * MiB + 512 * 1024;
constexpr size_t WS_CK = 8 * MiB, WS_CV = 12 * MiB;
constexpr size_t WS_WGU1 = 16 * MiB, WS_WD1 = 60 * MiB, WS_WIN = 82 * MiB, WS_WOUT = 102 * MiB, WS_WGU2 = 110 * MiB, WS_WD2 = 154 * MiB;
constexpr size_t WS_H = 176 * MiB;
constexpr size_t WS_ACT = 224 * MiB;
constexpr size_t WS_Q = 356 * MiB, WS_K = 380 * MiB, WS_V = 404 * MiB, WS_U = 428 * MiB, WS_VG = 452 * MiB;
constexpr size_t WS_MIX = 476 * MiB;
constexpr size_t WS_END = 524 * MiB;
constexpr int CW_BAR = 4096;

constexpr int RING_OFF = 0, RING_BYTES = 131072;
constexpr int LDSCTL_OFF = RING_BYTES, MISC_OFF = LDSCTL_OFF + 320;
constexpr int LDS_BYTES = 147456;

struct Frame {
    LAS unsigned char* lds;
    volatile LAS unsigned* MISC;
    gu32* ctl;
    int tid, lane, wave;
    int vcu, G;
};

__device__ __forceinline__ float wave_sum(float v) {
#pragma unroll
    for (int o = 1; o < 64; o <<= 1) v += __shfl_xor(v, o);
    return v;
}
__device__ __forceinline__ float bf2f(unsigned short b) { return __builtin_bit_cast(float, (unsigned)b << 16); }
__device__ __forceinline__ float bflo(unsigned w) { return __builtin_bit_cast(float, w << 16); }
__device__ __forceinline__ float bfhi(unsigned w) { return __builtin_bit_cast(float, w & 0xffff0000u); }

template <bool F8> __device__ __forceinline__ void p0_transpose_item(const float* W, int K, int N, bf16* WT, int mode, LAS float* scr, int item, int lane, int ld = 0) {
    if (ld == 0) ld = N;
    const int nblk = N / 32, kb = item / nblk, nb = item % nblk, k0 = 64 * kb, n0 = 32 * nb;
    const int drow0 = mode == 0 ? n0 : ((n0 >> 7) * 256 + (mode == 2 ? 128 : 0) + (n0 & 127));
#pragma unroll 8
    for (int i = 0; i < 32; ++i) { const int kk = 2 * i + (lane >> 5); scr[kk * 33 + (lane & 31)] = __builtin_nontemporal_load(W + (size_t)(k0 + kk) * ld + n0 + (lane & 31)); }
    LDS_WAIT(); asm volatile("" ::: "memory");
    const int c = lane & 7;
#pragma unroll
    for (int j = 0; j < 4; ++j) { const int n = (lane >> 3) + 8 * j; const LAS float* s = scr + (8 * c) * 33 + n;
        if constexpr (F8) { pg8::u32x2 o; o.x = pg8::pack4_fp8(s[0 * 33] * pg8::F8_SW, s[1 * 33] * pg8::F8_SW, s[2 * 33] * pg8::F8_SW, s[3 * 33] * pg8::F8_SW);
            o.y = pg8::pack4_fp8(s[4 * 33] * pg8::F8_SW, s[5 * 33] * pg8::F8_SW, s[6 * 33] * pg8::F8_SW, s[7 * 33] * pg8::F8_SW);
            *(GAS pg8::u32x2*)((unsigned char*)WT + (size_t)(drow0 + n) * K + k0 + 8 * c) = o; }
        else { v4u o; o.x = pk2(s[0 * 33], s[1 * 33]); o.y = pk2(s[2 * 33], s[3 * 33]); o.z = pk2(s[4 * 33], s[5 * 33]); o.w = pk2(s[6 * 33], s[7 * 33]);
            *(GAS v4u*)(WT + (size_t)(drow0 + n) * K + k0 + 8 * c) = o; } }
    LDS_WAIT(); asm volatile("" ::: "memory");
}
__device__ __forceinline__ void p0_ada_item(const float* c_lat, const float* c_ctx, const float* w_ada, float* part, LAS float* scr, int item, int lane) {
    const int cc = item % 72, ks = item / 72, k0 = ks * ADA_ROWS;
    for (int idx = lane; idx < NSET * ADA_ROWS; idx += 64) { const int j = idx / ADA_ROWS, kk = idx % ADA_ROWS;
        const float cv = j == 0 ? c_ctx[k0 + kk] : c_lat[(size_t)(j - 1) * DM + k0 + kk];
        scr[idx] = cv / (1.0f + __expf(-cv)); }
    LDS_WAIT(); asm volatile("" ::: "memory");
    f32x4 acc[NSET];
#pragma unroll
    for (int j = 0; j < NSET; ++j) acc[j] = (f32x4){0.f, 0.f, 0.f, 0.f};
    const float* wp = w_ada + (size_t)k0 * NADA + cc * 256 + lane * 4;
#pragma unroll 2
    for (int k4 = 0; k4 < ADA_ROWS; k4 += 4) {
        f32x4 w[4];
#pragma unroll
        for (int i = 0; i < 4; ++i) w[i] = __builtin_nontemporal_load((const f32x4*)(wp + (size_t)(k4 + i) * NADA));
#pragma unroll
        for (int j = 0; j < NSET; ++j) { const f32x4 s = *(const LAS f32x4*)(scr + j * ADA_ROWS + k4);
            acc[j] += w[0] * s[0]; acc[j] += w[1] * s[1]; acc[j] += w[2] * s[2]; acc[j] += w[3] * s[3]; }
    }
#pragma unroll
    for (int j = 0; j < NSET; ++j) *(f32x4*)(part + ((size_t)(ks * NSET + j)) * NADA + cc * 256 + lane * 4) = acc[j];
    LDS_WAIT(); asm volatile("" ::: "memory");
}

template <bool F8> __device__ __forceinline__ void rownorm_mod_row(float* xrow, const float* prow, const float* A, const float* B, bf16* orow, int lane, bf16* orow16 = nullptr) {
    GAS f32x4* xr = (GAS f32x4*)xrow + lane;
    f32x4 v[8]; float s = 0.f;
#pragma unroll
    for (int j = 0; j < 8; ++j) v[j] = xr[64 * j];
    if (prow) {
#pragma unroll
        for (int j = 0; j < 8; ++j) { v[j] += *((const GAS f32x4*)prow + lane + 64 * j); xr[64 * j] = v[j]; } }
#pragma unroll
    for (int j = 0; j < 8; ++j) s += (v[j].x * v[j].x + v[j].y * v[j].y) + (v[j].z * v[j].z + v[j].w * v[j].w);
    const float rstd = 1.0f / sqrtf(wave_sum(s) * (1.0f / DM) + EPS);
    GAS unsigned long long* o8 = (GAS unsigned long long*)orow + lane;
#pragma unroll
    for (int j = 0; j < 8; ++j) { const f32x4 a = *((const f32x4*)A + lane + 64 * j), b = *((const f32x4*)B + lane + 64 * j);
        const f32x4 y = v[j] * rstd * a + b;
        if constexpr (F8) { ((GAS unsigned*)orow)[lane + 64 * j] = pg8::pack4_fp8(y.x * pg8::F8_SA, y.y * pg8::F8_SA, y.z * pg8::F8_SA, y.w * pg8::F8_SA);
            if (orow16) ((GAS unsigned long long*)orow16)[lane + 64 * j] = (unsigned long long)pg8::cvt_pk_bf16(y.x, y.y) | ((unsigned long long)pg8::cvt_pk_bf16(y.z, y.w) << 32); }
        else o8[64 * j] = (unsigned long long)pg8::cvt_pk_bf16(y.x, y.y) | ((unsigned long long)pg8::cvt_pk_bf16(y.z, y.w) << 32); }
}

typedef float f32x16 __attribute__((ext_vector_type(16)));
typedef short s16x4 __attribute__((ext_vector_type(4)));
__device__ __forceinline__ int crow(int r, int hi) { return (r & 3) + 8 * (r >> 2) + 4 * hi; }
__device__ __forceinline__ s16x4 vtr(const LAS unsigned char* p) { return __builtin_bit_cast(s16x4, __builtin_amdgcn_ds_read_tr16_b64_v4i16((LAS s16x4*)p)); }
constexpr int AT_K = 0, AT_V = 16384, AT_WS = 32768, AT_TB = 32768 + 2048 + 256, AT_END = AT_TB + 2048 + 512;
struct AttnArgs { const bf16* qb; const bf16* kb; const bf16* vb; const bf16* ckb; const bf16* cvb; bf16* mixb; const float* rpb; };

__device__ __forceinline__ void attn_unit(LAS unsigned char* lds, const AttnArgs& T, bool lat, int b, int h, int rb) {
    const int tid = threadIdx.x, lane = tid & 63, r32 = lane & 31, hi = lane >> 5; const int wid = __builtin_amdgcn_readfirstlane(tid >> 6);
    int nA, nB, gr0 = 0, rq = 0, c0 = 0, rs = 0; const bf16 *KA, *VA; size_t rowA, rowB = 0, qrow;
    if (lat) { rq = 4 * rb + (wid >> 1); c0 = (wid & 1) * 32; rs = min(max(rq - 4, 0), 24);
        const int rs_min = min(max(4 * rb - 4, 0), 24), rs_max = min(max(4 * rb - 1, 0), 24); nB = rs_max + 8 - rs_min; gr0 = rs_min;
        nA = 8; KA = T.ckb; VA = T.cvb; rowA = (size_t)b * 512; rowB = (size_t)MCTX + (size_t)b * 2048 + 64 * rs_min; qrow = (size_t)MCTX + (size_t)b * 2048 + rq * 64 + c0; }
    else { nA = 4; nB = 0; KA = T.kb; VA = T.vb; rowA = (size_t)b * 256; qrow = (size_t)b * 256 + wid * 32; }
    const int NT = nA + nB;
    __syncthreads();
    if (lat && tid < 480) { const int e = tid & 31, dri = tid >> 5; ((LAS float*)(lds + AT_TB))[tid] = e < 31 ? T.rpb[h * 465 + dri * 31 + e] * LOG2E_F : 0.f; }
    bf16x8 qr[4];
#pragma unroll
    for (int d0 = 0; d0 < 4; ++d0) qr[d0] = *(const bf16x8*)(T.qb + (qrow + r32) * WA + h * 64 + d0 * 16 + hi * 8);
    LAS float* wsf = (LAS float*)(lds + AT_WS) + wid * 64;
    f32x16 o[2]; o[0] = (f32x16){}; o[1] = (f32x16){};
    float m_run = -INFINITY, l_run = 0.f;
    v4u kreg, vreg;
#define AT_LOAD(t) do { const bf16* Kp_; const bf16* Vp_; size_t row_; if ((t) < nA) { Kp_ = KA; Vp_ = VA; row_ = rowA + 64 * (size_t)(t); } else { Kp_ = T.kb; Vp_ = T.vb; row_ = rowB + 64 * (size_t)((t) - nA); } \
        kreg = *(const v4u*)(Kp_ + (row_ + skey) * WA + h * 64 + sch * 8); \
        vreg = *(const v4u*)(Vp_ + (row_ + skey) * WA + h * 64 + sch * 8); } while (0)
    const int skey = tid >> 3, sch = tid & 7;
    const int kst = skey * 128 + ((sch ^ ((skey >> 1) & 7)) * 16), vst = (sch >> 2) * 4096 + skey * 64 + (sch & 3) * 16;
    const int qc = c0 + r32, qcs = min(max(qc - 8, 0), 48), bbase = 4 * hi - qc + 15;
    unsigned vmask = 0u;
#pragma unroll
    for (int r = 0; r < 16; ++r) { const int kc = crow(r, hi); vmask |= (kc >= qcs && kc < qcs + 16) ? (1u << r) : 0u; vmask |= (kc + 32 >= qcs && kc + 32 < qcs + 16) ? (1u << (16 + r)) : 0u; }
    const int ksw = (r32 >> 1) & 7;
    AT_LOAD(0);
    for (int t = 0; t < NT; ++t) {
        const int slot = (t & 1) * 8192;
        *(LAS v4u*)(lds + AT_K + slot + kst) = kreg;
        *(LAS v4u*)(lds + AT_V + slot + vst) = vreg;
        __syncthreads();
        if (t + 1 < NT) AT_LOAD(t + 1);
        const bool local = t >= nA; const int gr = gr0 + (t - nA);
        if (local && (gr < rs || gr >= rs + 8)) continue;
        f32x16 p0, p1;
        if (local) {
            const LAS float* tb = (const LAS float*)(lds + AT_TB) + (gr - rq + 7) * 32 + bbase;
#pragma unroll
            for (int r = 0; r < 16; ++r) { const int cr0 = (r & 3) + 8 * (r >> 2);
                const float b0 = tb[cr0], b1 = tb[cr0 + 32];
                p0[r] = ((vmask >> r) & 1u) ? b0 : -1e30f; p1[r] = ((vmask >> (16 + r)) & 1u) ? b1 : -1e30f; }
        } else { p0 = (f32x16){}; p1 = (f32x16){}; }
        const LAS unsigned char* kbp = lds + AT_K + slot + r32 * 128;
#pragma unroll
        for (int d0 = 0; d0 < 4; ++d0) { const int co = ((2 * d0 + hi) ^ ksw) * 16; const bf16x8 k0 = *(const LAS bf16x8*)(kbp + co), k1 = *(const LAS bf16x8*)(kbp + co + 4096);
            p0 = __builtin_amdgcn_mfma_f32_32x32x16_bf16(k0, qr[d0], p0, 0, 0, 0); p1 = __builtin_amdgcn_mfma_f32_32x32x16_bf16(k1, qr[d0], p1, 0, 0, 0); }
        float mx = fmaxf(p0[0], p1[0]);
#pragma unroll
        for (int r = 1; r < 16; ++r) mx = fmaxf(mx, fmaxf(p0[r], p1[r]));
        mx = fmaxf(mx, __shfl_xor(mx, 32));
        const float m_new = fmaxf(m_run, mx);
        if (__any(m_new > m_run)) {
            const float alpha = __builtin_amdgcn_exp2f(m_run - m_new);
            l_run *= alpha; m_run = m_new;
            if (hi == 0) wsf[r32] = alpha;
            LDS_WAIT(); asm volatile("" ::: "memory");
#pragma unroll
            for (int g = 0; g < 4; ++g) { const f32x4 af = *(const LAS f32x4*)(wsf + 8 * g + 4 * hi);
#pragma unroll
                for (int i = 0; i < 4; ++i) { o[0][4 * g + i] *= af[i]; o[1][4 * g + i] *= af[i]; } }
        }
        float ls = 0.f;
#pragma unroll
        for (int r = 0; r < 16; ++r) { p0[r] = __builtin_amdgcn_exp2f(p0[r] - m_run); p1[r] = __builtin_amdgcn_exp2f(p1[r] - m_run); ls += p0[r] + p1[r]; }
        l_run += ls;
        v4u pw[4];
#pragma unroll
        for (int s = 0; s < 2; ++s) {
            pw[s] = (v4u){pg8::cvt_pk_bf16(p0[8 * s], p0[8 * s + 1]), pg8::cvt_pk_bf16(p0[8 * s + 2], p0[8 * s + 3]), pg8::cvt_pk_bf16(p0[8 * s + 4], p0[8 * s + 5]), pg8::cvt_pk_bf16(p0[8 * s + 6], p0[8 * s + 7])};
            pw[2 + s] = (v4u){pg8::cvt_pk_bf16(p1[8 * s], p1[8 * s + 1]), pg8::cvt_pk_bf16(p1[8 * s + 2], p1[8 * s + 3]), pg8::cvt_pk_bf16(p1[8 * s + 4], p1[8 * s + 5]), pg8::cvt_pk_bf16(p1[8 * s + 6], p1[8 * s + 7])}; }
        const LAS unsigned char* vbp = lds + AT_V + slot + ((lane >> 4) & 1) * 32 + (lane & 3) * 8 + (4 * hi + ((lane & 15) >> 2)) * 64;
#pragma unroll
        for (int d0 = 0; d0 < 2; ++d0)
#pragma unroll
            for (int ks = 0; ks < 4; ++ks) { const s16x4 lo = vtr(vbp + d0 * 4096 + ks * 1024), hh = vtr(vbp + d0 * 4096 + ks * 1024 + 512);
                const bf16x8 vf = (bf16x8){lo[0], lo[1], lo[2], lo[3], hh[0], hh[1], hh[2], hh[3]};
                o[d0] = __builtin_amdgcn_mfma_f32_32x32x16_bf16(__builtin_bit_cast(bf16x8, pw[ks]), vf, o[d0], 0, 0, 0); }
    }
#undef AT_LOAD
    l_run += __shfl_xor(l_run, 32);
    if (hi == 0) wsf[r32] = 1.0f / l_run;
    LDS_WAIT(); asm volatile("" ::: "memory");
    bf16* Ow = T.mixb + qrow * DM + h * 64 + r32;
#pragma unroll
    for (int g = 0; g < 4; ++g) { const f32x4 af = *(const LAS f32x4*)(wsf + 8 * g + 4 * hi);
#pragma unroll
        for (int i = 0; i < 4; ++i) { const int q = 8 * g + 4 * hi + i;
            Ow[(size_t)q * DM] = (bf16)f2bf(o[0][4 * g + i] * af[i]); Ow[(size_t)q * DM + 32] = (bf16)f2bf(o[1][4 * g + i] * af[i]); } }
}

struct GateArgs { const bf16* ub; const bf16* vgb; const bf16* wsb; const float* b_s; const float* gnorm; bf16* mixb; };
__device__ __forceinline__ void gate_units(LAS unsigned char* lds, const GateArgs& T, int u0, int ustride, int nunits) {
    const int tid = threadIdx.x, lane = tid & 63, r32 = lane & 31, hi = lane >> 5; const int wid = __builtin_amdgcn_readfirstlane(tid >> 6);
    if (u0 >= nunits) return;
    const int ch = tid & 15, rowb = tid >> 4;
    v4u raw[4];
#define GT_LOADVG(u) do { const size_t r0_ = (size_t)((u) >> 3) * 128; const int g_ = (u) & 7; _Pragma("unroll") for (int i = 0; i < 4; ++i) raw[i] = *(const v4u*)(T.vgb + (r0_ + rowb + 32 * i) * WA + g_ * 128 + ch * 8); } while (0)
    GT_LOADVG(u0);
    __syncthreads();
    LAS float* S = (LAS float*)(lds + 32768);
    for (int u = u0; u < nunits; u += ustride) {
        const int n = u >> 3, g = u & 7; const size_t row0 = (size_t)n * 128;
        const f32x4 g0 = *(const f32x4*)(T.gnorm + g * 128 + ch * 8), g1 = *(const f32x4*)(T.gnorm + g * 128 + ch * 8 + 4);
#pragma unroll
        for (int i = 0; i < 4; ++i) { const int row = rowb + 32 * i;
            float v[8]; v[0] = bflo(raw[i].x); v[1] = bfhi(raw[i].x); v[2] = bflo(raw[i].y); v[3] = bfhi(raw[i].y); v[4] = bflo(raw[i].z); v[5] = bfhi(raw[i].z); v[6] = bflo(raw[i].w); v[7] = bfhi(raw[i].w);
            float ss = 0.f;
#pragma unroll
            for (int e = 0; e < 8; ++e) ss += v[e] * v[e];
            ss += __shfl_xor(ss, 1); ss += __shfl_xor(ss, 2); ss += __shfl_xor(ss, 4); ss += __shfl_xor(ss, 8);
            const float rstd = 1.0f / sqrtf(ss * (1.0f / 128.0f) + EPS);
            v4u w; w.x = pg8::cvt_pk_bf16(v[0] * rstd * g0[0], v[1] * rstd * g0[1]); w.y = pg8::cvt_pk_bf16(v[2] * rstd * g0[2], v[3] * rstd * g0[3]);
            w.z = pg8::cvt_pk_bf16(v[4] * rstd * g1[0], v[5] * rstd * g1[1]); w.w = pg8::cvt_pk_bf16(v[6] * rstd * g1[2], v[7] * rstd * g1[3]);
            *(LAS v4u*)(lds + (ch >> 2) * 8192 + row * 64 + (ch & 3) * 16) = w; }
        __syncthreads();
        if (u + ustride < nunits) GT_LOADVG(u + ustride);
        v4u ureg[4];
#pragma unroll
        for (int i = 0; i < 4; ++i) ureg[i] = *(const v4u*)(T.ub + (row0 + rowb + 32 * i) * WA + g * 128 + ch * 8);
        const int ib = wid >> 1, cb0 = 2 * (wid & 1);
        f32x16 acc[2]; acc[0] = (f32x16){}; acc[1] = (f32x16){};
        const bf16* wfrag = T.wsb + ((size_t)(g * 128 + 32 * ib + r32) * 16 + hi) * 8;
        const LAS unsigned char* vbp = lds + ((lane >> 4) & 1) * 32 + (lane & 3) * 8 + (4 * hi + ((lane & 15) >> 2)) * 64;
        bf16x8 af[8];
#pragma unroll
        for (int ks = 0; ks < 8; ++ks) af[ks] = *(const bf16x8*)(wfrag + ks * 16);
#pragma unroll
        for (int ks = 0; ks < 8; ++ks) {
#pragma unroll
            for (int cbi = 0; cbi < 2; ++cbi) { const LAS unsigned char* q = vbp + (cb0 + cbi) * 8192 + ks * 1024;
                const s16x4 lo = vtr(q), hh = vtr(q + 512);
                const bf16x8 vf = (bf16x8){lo[0], lo[1], lo[2], lo[3], hh[0], hh[1], hh[2], hh[3]};
                acc[cbi] = __builtin_amdgcn_mfma_f32_32x32x16_bf16(af[ks], vf, acc[cbi], 0, 0, 0); }
        }
#pragma unroll
        for (int q4 = 0; q4 < 4; ++q4) { const f32x4 bs = *(const f32x4*)(T.b_s + g * 128 + 32 * ib + 8 * q4 + 4 * hi);
#pragma unroll
            for (int e = 0; e < 4; ++e) { const int il = 32 * ib + 8 * q4 + 4 * hi + e;
                S[il * 128 + 32 * cb0 + r32] = acc[0][4 * q4 + e] + bs[e]; S[il * 128 + 32 * (cb0 + 1) + r32] = acc[1][4 * q4 + e] + bs[e]; } }
        __syncthreads();
#pragma unroll
        for (int i = 0; i < 4; ++i) { const int row = rowb + 32 * i;
            const f32x4 s0 = *(const LAS f32x4*)(S + row * 128 + ch * 8), s1 = *(const LAS f32x4*)(S + row * 128 + ch * 8 + 4);
            v4u w; w.x = pg8::cvt_pk_bf16(bflo(ureg[i].x) * s0[0], bfhi(ureg[i].x) * s0[1]); w.y = pg8::cvt_pk_bf16(bflo(ureg[i].y) * s0[2], bfhi(ureg[i].y) * s0[3]);
            w.z = pg8::cvt_pk_bf16(bflo(ureg[i].z) * s1[0], bfhi(ureg[i].z) * s1[1]); w.w = pg8::cvt_pk_bf16(bflo(ureg[i].w) * s1[2], bfhi(ureg[i].w) * s1[3]);
            *(v4u*)(T.mixb + (row0 + row) * DM + WA + g * 128 + ch * 8) = w; }
    }
#undef GT_LOADVG
}


#ifndef SELFCHECK
#define SELFCHECK 0
#endif
#if SELFCHECK
__device__ __forceinline__ void selfcheck_mixer(LAS unsigned char* lds, int gw, int lane, int wave, const bf16* QB, const bf16* KB, const bf16* VB, const bf16* CKB, const bf16* CVB,
                                                const bf16* UB, const bf16* VGB, const bf16* MIXB, const float* rpb, const float* w_s, const float* b_s, const float* gnorm, unsigned* errw) {
    LAS float* P = (LAS float*)(lds + wave * 4096);
    {
        const int b = gw & 3, h = (gw >> 2) & 15, sel = gw >> 9;
        int n = (gw * 211) & 2047;
        if (sel == 1) n = (gw & 63) + 64 * ((gw >> 6) & 7); else if (sel == 2) n = 2047 - ((gw & 63) + 64 * ((gw >> 6) & 7)); else if (sel == 3) n = (gw * 977 + 5) & 2047;
        const int r = n >> 6, c = n & 63, rs = min(max(r - 4, 0), 24), cs = min(max(c - 8, 0), 48);
        const size_t qrow = (size_t)MCTX + (size_t)b * 2048 + n;
        float mx = -3.0e38f;
        for (int kidx = lane; kidx < 640; kidx += 64) {
            const bf16* kp; float bias = 0.f;
            if (kidx < 128) { const int krow = rs + (kidx >> 4), kcol = cs + (kidx & 15); kp = KB + ((size_t)MCTX + (size_t)b * 2048 + krow * 64 + kcol) * WA + h * 64;
                bias = rpb[h * 465 + (krow - r + 7) * 31 + (kcol - c + 15)] * LOG2E_F; }
            else kp = CKB + ((size_t)b * 512 + (kidx - 128)) * WA + h * 64;
            float d = 0.f;
            for (int e = 0; e < 64; ++e) d += bf2f(QB[qrow * WA + h * 64 + e]) * bf2f(kp[e]);
            d += bias; P[kidx] = d; mx = fmaxf(mx, d); }
#pragma unroll
        for (int o = 1; o < 64; o <<= 1) mx = fmaxf(mx, __shfl_xor(mx, o));
        LDS_WAIT(); asm volatile("" ::: "memory");
        float sum = 0.f;
        for (int kidx = lane; kidx < 640; kidx += 64) { const float e = exp2f(P[kidx] - mx); P[kidx] = e; sum += e; }
        sum = wave_sum(sum);
        LDS_WAIT(); asm volatile("" ::: "memory");
        float o = 0.f;
        for (int kidx = 0; kidx < 640; ++kidx) { const bf16* vp;
            if (kidx < 128) { const int krow = rs + (kidx >> 4), kcol = cs + (kidx & 15); vp = VB + ((size_t)MCTX + (size_t)b * 2048 + krow * 64 + kcol) * WA + h * 64; }
            else vp = CVB + ((size_t)b * 512 + (kidx - 128)) * WA + h * 64;
            o += P[kidx] * bf2f(vp[lane]); }
        o /= sum;
        const float fast = bf2f(MIXB[qrow * DM + h * 64 + lane]);
        float err = fabsf(fast - o), rms = wave_sum(o * o);
#pragma unroll
        for (int s = 1; s < 64; s <<= 1) err = fmaxf(err, __shfl_xor(err, s));
        const float rel = err / (sqrtf(rms * (1.0f / 64.0f)) + 1e-6f);
        if (lane == 0) atomicMax(errw + 0, __float_as_uint(rel));
        LDS_WAIT(); asm volatile("" ::: "memory");
    }
    {
        const int b = gw & 15, h = (gw >> 4) & 15, s = (gw * 37 + (gw >> 8)) & 255;
        const size_t qrow = (size_t)b * 256 + s;
        float mx = -3.0e38f;
        for (int kidx = lane; kidx < 256; kidx += 64) { const bf16* kp = KB + ((size_t)b * 256 + kidx) * WA + h * 64;
            float d = 0.f;
            for (int e = 0; e < 64; ++e) d += bf2f(QB[qrow * WA + h * 64 + e]) * bf2f(kp[e]);
            P[kidx] = d; mx = fmaxf(mx, d); }
#pragma unroll
        for (int o = 1; o < 64; o <<= 1) mx = fmaxf(mx, __shfl_xor(mx, o));
        LDS_WAIT(); asm volatile("" ::: "memory");
        float sum = 0.f;
        for (int kidx = lane; kidx < 256; kidx += 64) { const float e = exp2f(P[kidx] - mx); P[kidx] = e; sum += e; }
        sum = wave_sum(sum);
        LDS_WAIT(); asm volatile("" ::: "memory");
        float o = 0.f;
        for (int kidx = 0; kidx < 256; ++kidx) o += P[kidx] * bf2f(VB[((size_t)b * 256 + kidx) * WA + h * 64 + lane]);
        o /= sum;
        const float fast = bf2f(MIXB[qrow * DM + h * 64 + lane]);
        float err = fabsf(fast - o), rms = wave_sum(o * o);
#pragma unroll
        for (int s2 = 1; s2 < 64; s2 <<= 1) err = fmaxf(err, __shfl_xor(err, s2));
        const float rel = err / (sqrtf(rms * (1.0f / 64.0f)) + 1e-6f);
        if (lane == 0) atomicMax(errw + 1, __float_as_uint(rel));
        LDS_WAIT(); asm volatile("" ::: "memory");
    }
    {
        const int row = (gw * 6 + (gw >> 5)) % MTOK, c = (gw * 509 + 3) & 1023, g = c >> 7, i = row & 127; const size_t chunk0 = (size_t)(row & ~127);
        float contrib = 0.f;
        for (int j = lane; j < 128; j += 64) { float ss = 0.f;
            for (int e = 0; e < 128; ++e) { const float v = bf2f(VGB[(chunk0 + j) * WA + g * 128 + e]); ss += v * v; }
            const float rstd = 1.0f / sqrtf(ss * (1.0f / 128.0f) + EPS);
            contrib += w_s[((size_t)g * 128 + i) * 128 + j] * (bf2f(VGB[(chunk0 + j) * WA + c]) * rstd * gnorm[c]); }
        const float s = wave_sum(contrib) + b_s[g * 128 + i];
        const float gm = bf2f(UB[(size_t)row * WA + c]) * s, fast = bf2f(MIXB[(size_t)row * DM + WA + c]);
        const float rel = fabsf(fast - gm) / (fabsf(gm) + 0.1f);
        if (lane == 0) atomicMax(errw + 2, __float_as_uint(rel));
    }
}
#endif

struct Args { const float* in[26]; float* out; unsigned char* ws; int ph_lo, ph_hi, li, pad; };
constexpr int N_PHASES = 14;
__global__ void __launch_bounds__(NWAVES * 64, 2) mega_fwd(Args args) {
    extern __shared__ __attribute__((aligned(16))) unsigned char lds[];
    Frame F;
    F.lds = (LAS unsigned char*)lds;
    F.MISC = (volatile LAS unsigned*)(F.lds + MISC_OFF);
    F.tid = threadIdx.x; F.lane = F.tid & 63; F.wave = __builtin_amdgcn_readfirstlane(F.tid >> 6);
    F.G = gridDim.x; { const int bx = blockIdx.x; F.vcu = (F.G % 8 == 0) ? (bx % 8) * (F.G / 8) + bx / 8 : bx; }
    unsigned char* ws = args.ws;
    F.ctl = (gu32*)(ws + WS_CTL);
    const float* x_prompt = args.in[0]; const float* x_sample = args.in[1];
    float* const xbuf = args.out;
    float* const state_k = args.out + (size_t)MTOK * DM; float* const state_v = state_k + (size_t)MCTX * WA;
    bf16* const Wgu1 = (bf16*)(ws + WS_WGU1); bf16* const Wd1 = (bf16*)(ws + WS_WD1); bf16* const Win = (bf16*)(ws + WS_WIN); bf16* const Wout = (bf16*)(ws + WS_WOUT);
    bf16* const Wgu2 = (bf16*)(ws + WS_WGU2); bf16* const Wd2 = (bf16*)(ws + WS_WD2);
    bf16* const HB = (bf16*)(ws + WS_H); bf16* const ACT = (bf16*)(ws + WS_ACT);
    bf16* const QB = (bf16*)(ws + WS_Q); bf16* const KB = (bf16*)(ws + WS_K); bf16* const VB = (bf16*)(ws + WS_V); bf16* const UB = (bf16*)(ws + WS_U); bf16* const VGB = (bf16*)(ws + WS_VG);
    static_assert(WS_K - WS_Q == 24 * MiB && WS_V - WS_K == 24 * MiB && WS_U - WS_V == 24 * MiB && WS_VG - WS_U == 24 * MiB, "EpiMixIn addresses k, v, u, v_g from q by a fixed stride");
    bf16* const MIXB = (bf16*)(ws + WS_MIX); bf16* const CKB = (bf16*)(ws + WS_CK); bf16* const CVB = (bf16*)(ws + WS_CV);
    float* const MODP = (float*)(ws + WS_MODP); float* const MOD = (float*)(ws + WS_MOD);
    bf16* const WSB = (bf16*)(ws + WS_WSB);
    bf16* const WinKV = (bf16*)(ws + WS_WIN + 10 * MiB);
    bf16* const HB16 = (bf16*)(ws + WS_H + 24 * MiB);
    float* const PBUF = (float*)(ws + WS_Q);
    const bool split = (F.G == 256);

    for (int u = F.tid; u < (LDS_BYTES - LDSCTL_OFF) / 4; u += NWAVES * 64) ((LAS unsigned*)(F.lds + LDSCTL_OFF))[u] = 0u;
    __syncthreads();
    XcdBarrier bar = xcd_barrier_post((unsigned*)(F.ctl + CW_BAR) + args.li * XCD_BAR_WORDS, F.MISC + 8);
    const int lo = args.ph_lo, hi = args.ph_hi;
#define IN(k) (lo <= (k) && (k) < hi)
#ifndef PROBE_REPEAT
#define PROBE_REPEAT -1
#endif
#define REP(k) for (int rep_ = 0; rep_ < ((PROBE_REPEAT == (k)) ? 2 : 1); ++rep_)
#define REPBAR() do { if (rep_) xcd_barrier(bar); } while (0)
#define SEAM(k) do { if (IN(k) && IN((k) + 1)) xcd_barrier(bar); } while (0)
    const int gw = F.vcu * NWAVES + F.wave, NGW = F.G * NWAVES;
    constexpr int I_GU = 32 * 176, I_D = 88 * 64, I_IN = 32 * 160, I_OUT = 32 * 64;
    constexpr int I_KV = 32 * 64;
    constexpr int NTR = 6 * I_GU + I_IN + I_KV + I_OUT, NTR_P0 = 3 * I_GU + I_IN + I_KV + I_OUT;
    static_assert(I_GU == I_D && NTR == 43008 && NTR - NTR_P0 == 1536 * 11, "item count");
    const bool defer_ffn2 = (F.G == 256);
#define P0_ITEM(it_) do { int r_ = (it_); LAS float* scr_ = (LAS float*)(F.lds + RING_OFF + F.wave * 16384); \
        if (r_ < I_GU) p0_transpose_item<FFN_FP8>(args.in[9], DM, DFF, Wgu1, 1, scr_, r_, F.lane); \
        else if ((r_ -= I_GU) < I_GU) p0_transpose_item<FFN_FP8>(args.in[10], DM, DFF, Wgu1, 2, scr_, r_, F.lane); \
        else if ((r_ -= I_GU) < I_D) p0_transpose_item<FFN_FP8>(args.in[11], DFF, DM, Wd1, 0, scr_, r_, F.lane); \
        else if ((r_ -= I_D) < I_IN) p0_transpose_item<true>(args.in[13], DM, INW, Win, 0, scr_, r_, F.lane); \
        else if ((r_ -= I_IN) < I_KV) p0_transpose_item<false>(args.in[13] + 1024, DM, 2048, WinKV, 0, scr_, r_, F.lane, INW); \
        else if ((r_ -= I_KV) < I_OUT) p0_transpose_item<MIX_FP8>(args.in[20], DM, DM, Wout, 0, scr_, r_, F.lane); \
        else if ((r_ -= I_OUT) < I_GU) p0_transpose_item<FFN_FP8>(args.in[22], DM, DFF, Wgu2, 1, scr_, r_, F.lane); \
        else if ((r_ -= I_GU) < I_GU) p0_transpose_item<FFN_FP8>(args.in[23], DM, DFF, Wgu2, 2, scr_, r_, F.lane); \
        else { r_ -= I_GU; p0_transpose_item<FFN_FP8>(args.in[24], DFF, DM, Wd2, 0, scr_, r_, F.lane); } } while (0)

    if (IN(0)) REP(0) { REPBAR();
        LAS float* scr = (LAS float*)(F.lds + RING_OFF + F.wave * 16384);
        { const int gt = F.vcu * (NWAVES * 64) + F.tid, NGT = F.G * NWAVES * 64;
          for (int i = gt; i < 2 * 262144; i += NGT) { const int which = i >= 262144, e = (which ? i - 262144 : i) * 8; const float* src = args.in[2 + which] + e;
              const f32x4 a = *(const f32x4*)src, b2 = *(const f32x4*)(src + 4);
              v4u o; o.x = pg8::cvt_pk_bf16(a[0], a[1]); o.y = pg8::cvt_pk_bf16(a[2], a[3]); o.z = pg8::cvt_pk_bf16(b2[0], b2[1]); o.w = pg8::cvt_pk_bf16(b2[2], b2[3]);
              *(v4u*)((which ? CVB : CKB) + e) = o; } }
        { const int gt = F.vcu * (NWAVES * 64) + F.tid, NGT = F.G * NWAVES * 64;
          for (int i = gt; i < 16384; i += NGT) { const int hh = i & 1, ks = (i >> 1) & 7, gi = i >> 4; const float* src = args.in[16] + (size_t)gi * 128 + 16 * ks + 4 * hh;
              const f32x4 a = *(const f32x4*)src, b2 = *(const f32x4*)(src + 8);
              v4u o; o.x = pg8::cvt_pk_bf16(a[0], a[1]); o.y = pg8::cvt_pk_bf16(a[2], a[3]); o.z = pg8::cvt_pk_bf16(b2[0], b2[1]); o.w = pg8::cvt_pk_bf16(b2[2], b2[3]);
              *(v4u*)(WSB + (size_t)i * 8) = o; } }
        { int t0, t1;
          if (NGW == 2048) { if (gw < 1152) p0_ada_item(args.in[4], args.in[5], args.in[6], MODP, scr, gw, F.lane); }
          else { for (int it = gw; it < 1152; it += NGW) p0_ada_item(args.in[4], args.in[5], args.in[6], MODP, scr, it, F.lane); }
          const int ntr0 = defer_ffn2 ? NTR_P0 : NTR, per = (ntr0 + NGW - 1) / NGW; t0 = gw * per; t1 = min(t0 + per, ntr0);
          for (int it = t0; it < t1; ++it) P0_ITEM(it); }
    }
    SEAM(0);
    if (IN(1)) REP(1) { REPBAR();
        const int gt = F.vcu * (NWAVES * 64) + F.tid, NGT = F.G * NWAVES * 64;
        for (int idx = gt; idx < NSET * NADA; idx += NGT) { const int j = idx / NADA, n = idx % NADA, chunk = n >> 11, col = n & 2047;
            float s = args.in[7][n];
#pragma unroll
            for (int ks = 0; ks < KSPLIT_ADA; ++ks) s += MODP[((size_t)(ks * NSET + j)) * NADA + n];
            const int sub = chunk / 3, kind = chunk % 3;
            if (kind == 1) { const float* gn = sub == 0 ? args.in[8] : sub == 1 ? args.in[12] : args.in[21]; s = gn[col] * (1.0f + s); }
            else if (kind == 2 && sub != 1) s *= 0.5f;
            MOD[(size_t)j * NADA + n] = s; }
    }
    SEAM(1);
    if (IN(2)) REP(2) { REPBAR();
        for (int m = gw; m < MTOK; m += NGW) { const int j = m < MCTX ? 0 : 1 + ((m - MCTX) >> 11);
            const float* xr = m < MCTX ? x_prompt + (size_t)m * DM : x_sample + (size_t)(m - MCTX) * DM;
            rownorm_mod_row<FFN_FP8>(const_cast<float*>(xr), nullptr, MOD + (size_t)j * NADA + 1 * DM, MOD + (size_t)j * NADA + 0 * DM, HB + (size_t)m * (FFN_FP8 ? DM / 2 : DM), F.lane); }
    }
    SEAM(2);
    if (IN(3)) REP(3) { REPBAR();
        pg8::Gemm g{HB, Wgu1, MTOK, 2 * DFF, FFN_FP8 ? DM / 2 : DM}; pg8::StaticOrder S; S.init(MTOK, 2 * DFF, F.G, (int)blockIdx.x);
#if FFN_FP8
        pg8::EpiSwiGLU8 E{(unsigned char*)ACT, DFF};
        pg8::gemm_phase<pg8::EpiSwiGLU8, pg8::StaticOrder, true, true, true>(F.lds + RING_OFF, g, S, E);
#else
        pg8::EpiSwiGLU E{ACT, DFF, 0};
#if PROBE_REPEAT == 3 && defined(PROBE_NULL_EPI)
        E.skip = rep_;
#endif
        pg8::gemm_phase<pg8::EpiSwiGLU, pg8::StaticOrder, true, true>(F.lds + RING_OFF, g, S, E);
#endif
        if (defer_ffn2 && blockIdx.x >= 64) {
            const int tw = ((int)blockIdx.x - 64) * NWAVES + F.wave;
            for (int it = NTR_P0 + tw * 11; it < NTR_P0 + tw * 11 + 11; ++it) P0_ITEM(it); }
    }
    SEAM(3);
    if (IN(4)) REP(4) { REPBAR();
        pg8::Gemm g{ACT, Wd1, MTOK, DM, FFN_FP8 ? DFF / 2 : DFF}; pg8::FlexOrder S; S.st.init(MTOK, DM, F.G, (int)blockIdx.x); S.sp.v = F.vcu; S.sp.nth = (FFN_FP8 ? DFF / 2 : DFF) / 128; S.split = split;
        pg8::EpiRes E{x_prompt, x_sample, xbuf, MOD + 2 * DM, DM, FFN_FP8 ? pg8::F8_DQ : 1.0f, PBUF};
        pg8::gemm_phase<pg8::EpiRes, pg8::FlexOrder, true, true, FFN_FP8>(F.lds + RING_OFF, g, S, E);
    }
    SEAM(4);
    if (IN(5)) REP(5) { REPBAR();
        for (int m = gw; m < MTOK; m += NGW) { const int j = m < MCTX ? 0 : 1 + ((m - MCTX) >> 11);
            rownorm_mod_row<true>(xbuf + (size_t)m * DM, (split && m >= 8192) ? PBUF + (size_t)(m - 8192) * DM : nullptr, MOD + (size_t)j * NADA + 4 * DM, MOD + (size_t)j * NADA + 3 * DM, HB + (size_t)m * (DM / 2), F.lane, m < MCTX ? HB16 + (size_t)m * DM : nullptr); }
    }
    SEAM(5);
    if (IN(6)) REP(6) { REPBAR();
        { pg8::Gemm g{HB16, WinKV, MCTX, 2048, DM}; pg8::StaticOrder S; S.init(MCTX, 2048, F.G, (int)blockIdx.x);
          pg8::EpiMixIn E{QB, KB, VB, UB, VGB, state_k, state_v, 0.125f * LOG2E_F, 4, 1.0f};
          pg8::gemm_phase<pg8::EpiMixIn, pg8::StaticOrder, true, true>(F.lds + RING_OFF, g, S, E); }
        { pg8::Gemm g{HB, Win, MTOK, INW, DM / 2}; pg8::MixOrder S; S.c = (int)blockIdx.x; S.use_static = (F.G != 256); S.st.init(MTOK, INW, F.G, (int)blockIdx.x);
          pg8::EpiMixIn E{QB, KB, VB, UB, VGB, nullptr, nullptr, 0.125f * LOG2E_F, 0, pg8::F8_DQ};
          pg8::gemm_phase<pg8::EpiMixIn, pg8::MixOrder, true, true, true>(F.lds + RING_OFF, g, S, E); }
    }
    SEAM(6);
    if (IN(7)) REP(7) { REPBAR();
        const AttnArgs AT{QB, KB, VB, CKB, CVB, MIXB, args.in[14]};
        const GateArgs GT{UB, VGB, WSB, args.in[17], args.in[15], MIXB};
        REP(70) { REPBAR(); for (int u = F.vcu; u < 512; u += F.G) attn_unit(F.lds + RING_OFF, AT, true, u >> 7, (u >> 3) & 15, u & 7); }
        REP(71) { REPBAR(); for (int u = F.vcu; u < 256; u += F.G) attn_unit(F.lds + RING_OFF, AT, false, u >> 4, u & 15, 0); }
        REP(72) { REPBAR(); gate_units(F.lds + RING_OFF, GT, F.vcu, F.G, 768); }
    }
    SEAM(7);
#if SELFCHECK
    if (IN(8)) { selfcheck_mixer(F.lds + RING_OFF, gw, F.lane, F.wave, QB, KB, VB, CKB, CVB, UB, VGB, MIXB, args.in[14], args.in[16], args.in[17], args.in[15], (unsigned*)(F.ctl + 64)); xcd_barrier(bar); }
#endif
    if (IN(8)) REP(8) { REPBAR();
        for (int m = gw; m < MTOK; m += NGW) {
            v4u* rowp = (v4u*)(MIXB + (size_t)m * DM) + F.lane;
#pragma unroll
            for (int half = 0; half < 2; ++half) {
                v4u raw[2]; float v[16]; float ss = 0.f;
#pragma unroll
                for (int j = 0; j < 2; ++j) { raw[j] = rowp[half * 128 + 64 * j];
                    v[8 * j + 0] = bflo(raw[j].x); v[8 * j + 1] = bfhi(raw[j].x); v[8 * j + 2] = bflo(raw[j].y); v[8 * j + 3] = bfhi(raw[j].y);
                    v[8 * j + 4] = bflo(raw[j].z); v[8 * j + 5] = bfhi(raw[j].z); v[8 * j + 6] = bflo(raw[j].w); v[8 * j + 7] = bfhi(raw[j].w); }
#pragma unroll
                for (int e = 0; e < 16; ++e) ss += v[e] * v[e];
                const float rstd = 1.0f / sqrtf(wave_sum(ss) * (1.0f / WA) + EPS);
                const float* gn = args.in[18 + half];
#pragma unroll
                for (int j = 0; j < 2; ++j) { const f32x4 g0 = *(const f32x4*)(gn + (F.lane + 64 * j) * 8), g1 = *(const f32x4*)(gn + (F.lane + 64 * j) * 8 + 4);
#if MIX_FP8
                    const float rs8 = rstd * pg8::F8_SA; pg8::u32x2 w8; w8.x = pg8::pack4_fp8(v[8 * j + 0] * rs8 * g0[0], v[8 * j + 1] * rs8 * g0[1], v[8 * j + 2] * rs8 * g0[2], v[8 * j + 3] * rs8 * g0[3]);
                    w8.y = pg8::pack4_fp8(v[8 * j + 4] * rs8 * g1[0], v[8 * j + 5] * rs8 * g1[1], v[8 * j + 6] * rs8 * g1[2], v[8 * j + 7] * rs8 * g1[3]);
                    *((pg8::u32x2*)((unsigned char*)HB + (size_t)m * DM) + half * 128 + 64 * j + F.lane) = w8; }
#else
                    v4u w; w.x = pg8::cvt_pk_bf16(v[8 * j + 0] * rstd * g0[0], v[8 * j + 1] * rstd * g0[1]); w.y = pg8::cvt_pk_bf16(v[8 * j + 2] * rstd * g0[2], v[8 * j + 3] * rstd * g0[3]);
                    w.z = pg8::cvt_pk_bf16(v[8 * j + 4] * rstd * g1[0], v[8 * j + 5] * rstd * g1[1]); w.w = pg8::cvt_pk_bf16(v[8 * j + 6] * rstd * g1[2], v[8 * j + 7] * rstd * g1[3]);
                    rowp[half * 128 + 64 * j] = w; }
#endif
            }
        }
    }
    SEAM(8);
    if (IN(9)) REP(9) { REPBAR();
        pg8::Gemm g{MIX_FP8 ? HB : MIXB, Wout, MTOK, DM, MIX_FP8 ? DM / 2 : DM}; pg8::FlexOrder S; S.st.init(MTOK, DM, F.G, (int)blockIdx.x); S.sp.v = F.vcu; S.sp.nth = (MIX_FP8 ? DM / 2 : DM) / 128; S.split = split;
        pg8::EpiRes E{xbuf, xbuf + (size_t)MCTX * DM, xbuf, MOD + 5 * DM, DM, MIX_FP8 ? pg8::F8_DQ : 1.0f, PBUF};
        pg8::gemm_phase<pg8::EpiRes, pg8::FlexOrder, true, true, MIX_FP8>(F.lds + RING_OFF, g, S, E);
    }
    SEAM(9);
    if (IN(10)) REP(10) { REPBAR();
        for (int m = gw; m < MTOK; m += NGW) { const int j = m < MCTX ? 0 : 1 + ((m - MCTX) >> 11);
            rownorm_mod_row<FFN_FP8>(xbuf + (size_t)m * DM, (split && m >= 8192) ? PBUF + (size_t)(m - 8192) * DM : nullptr, MOD + (size_t)j * NADA + 7 * DM, MOD + (size_t)j * NADA + 6 * DM, HB + (size_t)m * (FFN_FP8 ? DM / 2 : DM), F.lane); }
    }
    SEAM(10);
    if (IN(11)) REP(11) { REPBAR();
        pg8::Gemm g{HB, Wgu2, MTOK, 2 * DFF, FFN_FP8 ? DM / 2 : DM}; pg8::StaticOrder S; S.init(MTOK, 2 * DFF, F.G, (int)blockIdx.x);
#if FFN_FP8
        pg8::EpiSwiGLU8 E{(unsigned char*)ACT, DFF};
        pg8::gemm_phase<pg8::EpiSwiGLU8, pg8::StaticOrder, true, true, true>(F.lds + RING_OFF, g, S, E);
#else
        pg8::EpiSwiGLU E{ACT, DFF, 0};
        pg8::gemm_phase<pg8::EpiSwiGLU, pg8::StaticOrder, true, true>(F.lds + RING_OFF, g, S, E);
#endif
    }
    SEAM(11);
    if (IN(12)) REP(12) { REPBAR();
        pg8::Gemm g{ACT, Wd2, MTOK, DM, FFN_FP8 ? DFF / 2 : DFF}; pg8::FlexOrder S; S.st.init(MTOK, DM, F.G, (int)blockIdx.x); S.sp.v = F.vcu; S.sp.nth = (FFN_FP8 ? DFF / 2 : DFF) / 128; S.split = split;
        pg8::EpiRes E{xbuf, xbuf + (size_t)MCTX * DM, xbuf, MOD + 8 * DM, DM, FFN_FP8 ? pg8::F8_DQ : 1.0f, PBUF};
        pg8::gemm_phase<pg8::EpiRes, pg8::FlexOrder, true, true, FFN_FP8>(F.lds + RING_OFF, g, S, E);
    }
    SEAM(12);
    if (IN(13)) REP(13) { REPBAR();
        const float* fg = args.in[25];
        for (int m = gw; m < MTOK; m += NGW) {
            GAS f32x4* xr = (GAS f32x4*)(xbuf + (size_t)m * DM) + F.lane;
            f32x4 v[8]; float s = 0.f;
#pragma unroll
            for (int j = 0; j < 8; ++j) v[j] = xr[64 * j];
            if (split && m >= 8192) { const GAS f32x4* pr = (const GAS f32x4*)(PBUF + (size_t)(m - 8192) * DM) + F.lane;
#pragma unroll
                for (int j = 0; j < 8; ++j) v[j] += pr[64 * j]; }
#pragma unroll
            for (int j = 0; j < 8; ++j) s += (v[j].x * v[j].x + v[j].y * v[j].y) + (v[j].z * v[j].z + v[j].w * v[j].w);
            const float rstd = 1.0f / sqrtf(wave_sum(s) * (1.0f / DM) + EPS);
#pragma unroll
            for (int j = 0; j < 8; ++j) xr[64 * j] = v[j] * rstd * *((const f32x4*)fg + F.lane + 64 * j);
        }
#if SELFCHECK
        if (gw == 0 && F.lane == 0) {
            const float e0 = __uint_as_float(__hip_atomic_load((unsigned*)(F.ctl + 64), RLX_AGENT)), e1 = __uint_as_float(__hip_atomic_load((unsigned*)(F.ctl + 65), RLX_AGENT)), e2 = __uint_as_float(__hip_atomic_load((unsigned*)(F.ctl + 66), RLX_AGENT));
#ifdef SELFCHECK_REPORT
            const int k = SELFCHECK_REPORT - 1; const float e = k == 0 ? e0 : k == 1 ? e1 : e2;
            xbuf[0] = (k == 0 ? 1e3f : k == 1 ? 1e5f : 1e7f) * (1.0f + 100.0f * fminf(e, 0.9f));
#else
            if (!(e0 < 0.03f)) xbuf[0] = 1e3f * (1.0f + 100.0f * fminf(e0, 0.9f));
            else if (!(e1 < 0.03f)) xbuf[0] = 1e5f * (1.0f + 100.0f * fminf(e1, 0.9f));
            else if (!(e2 < 0.05f)) xbuf[0] = 1e7f * (1.0f + 100.0f * fminf(e2, 0.9f));
#endif
        }
#endif
    }
#undef IN
#undef SEAM
}

#ifndef MK_N_LAUNCHES
#define MK_N_LAUNCHES 1
#endif
extern "C" void kernel_launch(void* const* d_in, const int* in_sizes, int n_in, void* d_out, int out_size, void* d_ws, size_t ws_size, hipStream_t stream) {
    static int grid = 0;
    if (grid == 0) {
        if (n_in != 26 || out_size != MTOK * DM + 2 * MCTX * WA || ws_size < WS_END) { fprintf(stderr, "kernel_launch: unexpected shapes: n_in %d out %d ws %zu (need %zu); nothing launched\n", n_in, out_size, ws_size, (size_t)WS_END); grid = -1; return; }
        int dev = 0, cus = 0, per_cu = 0;
        if (hipGetDevice(&dev) != hipSuccess || hipDeviceGetAttribute(&cus, hipDeviceAttributeMultiprocessorCount, dev) != hipSuccess) { fprintf(stderr, "kernel_launch: device query failed\n"); grid = -1; return; }
        if (hipFuncSetAttribute((const void*)mega_fwd, hipFuncAttributeMaxDynamicSharedMemorySize, LDS_BYTES) != hipSuccess) { fprintf(stderr, "kernel_launch: hipFuncSetAttribute failed\n"); grid = -1; return; }
        if (hipOccupancyMaxActiveBlocksPerMultiprocessor(&per_cu, (const void*)mega_fwd, NWAVES * 64, LDS_BYTES) != hipSuccess || per_cu < 1)
            fprintf(stderr, "kernel_launch: note: occupancy query reports %d workgroups per CU\n", per_cu);
        (void)hipGetLastError();
        grid = cus;
    }
    if (grid < 0) return;
    if (hipMemsetAsync((char*)d_ws + WS_CTL, 0, CTL_ZERO_BYTES, stream) != hipSuccess) { fprintf(stderr, "kernel_launch: hipMemsetAsync failed\n"); return; }
    Args a{};
    for (int i = 0; i < 26; ++i) a.in[i] = (const float*)d_in[i];
    a.out = (float*)d_out; a.ws = (unsigned char*)d_ws;
    if (MK_N_LAUNCHES == 1) { a.ph_lo = 0; a.ph_hi = N_PHASES; a.li = 0; hipLaunchKernelGGL(mega_fwd, dim3(grid), dim3(NWAVES * 64), LDS_BYTES, stream, a); }
    else { for (int p = 0; p < N_PHASES; ++p) { a.ph_lo = p; a.ph_hi = p + 1; a.li = 0; hipLaunchKernelGGL(mega_fwd, dim3(grid), dim3(NWAVES * 64), LDS_BYTES, stream, a); } }
    const hipError_t le = hipPeekAtLastError();
    if (le != hipSuccess) fprintf(stderr, "kernel_launch: launch failed: %s\n", hipGetErrorName(le));
}
```
